# Optimizing an MI355X kernel written in HIP

```python
import math
import jax, jax.numpy as jnp
from jax import lax
import numpy as np

D_MODEL = 1024
BATCH = 8
SEQ = 2048
DEPTH = 2

CHUNK = 64
N_MIXERS = 2
N_A = (DEPTH + 1) // 2
N_B = DEPTH // 2
GMLP_BLOCK = 128
D_GATE = 2 * D_MODEL
A_GROUPS = 8
A_GROUP_DIM = D_GATE // A_GROUPS
CONV_WIDTH = 3
D_FF = 4 * D_MODEL
LN_EPS = 1e-5
DEEPNORM_ALPHA = (2.0 * DEPTH) ** 0.25
DEEPNORM_BETA = (8.0 * DEPTH) ** -0.25

kernel_name = "hybrid_sgu_shortconv_deepnorm_trunk"


def layer_norm(x, g, b):
    xf = x.astype(jnp.float32)
    mu = jnp.mean(xf, axis=-1, keepdims=True)
    var = jnp.mean(jnp.square(xf - mu), axis=-1, keepdims=True)
    y = (xf - mu) * lax.rsqrt(var + LN_EPS) * g.astype(jnp.float32) + b.astype(jnp.float32)
    return y.astype(x.dtype)


def spatial_gating_mixer(x, w_in, b_in, v_g, v_b, w_s, b_s, w_out, b_out):
    bsz, seq, _ = x.shape
    h = jax.nn.gelu(x @ w_in + b_in, approximate=False)
    u, v = h[..., :D_GATE], h[..., D_GATE:]
    v = layer_norm(v, v_g, v_b)
    v = v.reshape(bsz, seq // GMLP_BLOCK, GMLP_BLOCK, A_GROUPS, A_GROUP_DIM)
    chunk_id = jnp.arange(GMLP_BLOCK) // CHUNK
    mask = chunk_id[:, None] >= chunk_id[None, :]
    w = jnp.where(mask[None], w_s, jnp.zeros_like(w_s))
    v = jnp.einsum('gts,bnsgc->bntgc', w, v) + b_s.T[None, None, :, :, None]
    y = u * v.reshape(bsz, seq, D_GATE)
    return y @ w_out + b_out


def short_conv_mixer(x, w_in, conv_w, w_out):
    bch = x @ w_in
    b_gate = bch[..., :D_MODEL]
    c_gate = bch[..., D_MODEL:2 * D_MODEL]
    h = bch[..., 2 * D_MODEL:]
    h = c_gate * h
    h = lax.conv_general_dilated(
        h, conv_w[:, None, :].astype(h.dtype),
        window_strides=(1,), padding=[(CONV_WIDTH - 1, 0)],
        dimension_numbers=('NWC', 'WIO', 'NWC'),
        feature_group_count=D_MODEL)
    return (b_gate * h) @ w_out


def squared_relu_mlp(x, w1, w2):
    return jnp.square(jax.nn.relu(x @ w1)) @ w2


def setup_inputs(seed: int = 0) -> dict:
    key = jax.random.key(seed)
    ks = jax.random.split(key, 20)
    f32 = jnp.float32
    nrm = lambda k, shape, scale: jax.random.normal(k, shape, f32) * scale
    x = jax.random.normal(ks[0], (BATCH, SEQ, D_MODEL), f32)
    ln_g = 1.0 + nrm(ks[1], (DEPTH, 2, D_MODEL), 0.02)
    ln_b = nrm(ks[2], (DEPTH, 2, D_MODEL), 0.02)
    a_w_in = nrm(ks[3], (N_A, D_MODEL, 2 * D_GATE), D_MODEL ** -0.5)
    a_b_in = nrm(ks[4], (N_A, 2 * D_GATE), 0.02)
    a_v_g = 1.0 + nrm(ks[5], (N_A, D_GATE), 0.02)
    a_v_b = nrm(ks[6], (N_A, D_GATE), 0.02)
    a_w_s = nrm(ks[7], (N_A, A_GROUPS, GMLP_BLOCK, GMLP_BLOCK), GMLP_BLOCK ** -0.5)
    a_b_s = 1.0 + nrm(ks[8], (N_A, A_GROUPS, GMLP_BLOCK), 0.02)
    a_w_out = nrm(ks[9], (N_A, D_GATE, D_MODEL), DEEPNORM_BETA * D_GATE ** -0.5)
    a_b_out = nrm(ks[10], (N_A, D_MODEL), 0.02)
    b_w_in = nrm(ks[11], (N_B, D_MODEL, 3 * D_MODEL), D_MODEL ** -0.5)
    b_conv = nrm(ks[12], (N_B, CONV_WIDTH, D_MODEL), CONV_WIDTH ** -0.5)
    b_w_out = nrm(ks[13], (N_B, D_MODEL, D_MODEL), DEEPNORM_BETA * D_MODEL ** -0.5)
    mlp_w1 = nrm(ks[14], (DEPTH, D_MODEL, D_FF), D_MODEL ** -0.5)
    mlp_w2 = nrm(ks[15], (DEPTH, D_FF, D_MODEL), DEEPNORM_BETA * D_FF ** -0.5)
    return {"x": x, "ln_g": ln_g, "ln_b": ln_b,
            "a_w_in": a_w_in, "a_b_in": a_b_in, "a_v_g": a_v_g, "a_v_b": a_v_b,
            "a_w_s": a_w_s, "a_b_s": a_b_s, "a_w_out": a_w_out, "a_b_out": a_b_out,
            "b_w_in": b_w_in, "b_conv": b_conv, "b_w_out": b_w_out,
            "mlp_w1": mlp_w1, "mlp_w2": mlp_w2}


def reference(x, ln_g, ln_b, a_w_in, a_b_in, a_v_g, a_v_b, a_w_s, a_b_s, a_w_out,
              a_b_out, b_w_in, b_conv, b_w_out, mlp_w1, mlp_w2):
    alpha = jnp.asarray(DEEPNORM_ALPHA, x.dtype)
    for i in range(DEPTH):
        j = i // N_MIXERS
        if i % N_MIXERS == 0:
            mix = spatial_gating_mixer(x, a_w_in[j], a_b_in[j], a_v_g[j], a_v_b[j],
                                       a_w_s[j], a_b_s[j], a_w_out[j], a_b_out[j])
        else:
            mix = short_conv_mixer(x, b_w_in[j], b_conv[j], b_w_out[j])
        x = layer_norm(alpha * x + mix, ln_g[i, 0], ln_b[i, 0])
        x = layer_norm(alpha * x + squared_relu_mlp(x, mlp_w1[i], mlp_w2[i]),
                       ln_g[i, 1], ln_b[i, 1])
    return x
```

```cpp
#include <hip/hip_runtime.h>
#include <hip/hip_cooperative_groups.h>
#include <cstdio>
#include <cstdint>
namespace cg = cooperative_groups;
namespace pg8 {
#define PG8_LAS __attribute__((address_space(3)))
typedef unsigned short bf16_t;
typedef short bf16x8 __attribute__((ext_vector_type(8)));
typedef float f32x4 __attribute__((ext_vector_type(4)));
typedef unsigned u32x4 __attribute__((ext_vector_type(4)));
constexpr int BM = 256, BK = 64, HALF = 128, HTB = HALF * BK * 2  , STAGE_BYTES = 8 * HTB, NXCD = 8, WGM = 8;

__host__ __device__ __forceinline__ int lds_byte(int r, int c) { const int st = (r >> 4) * 2 + (c >> 5), rr = r & 15, cc = c & 31, ob = rr * 64 + cc * 2; return st * 1024 + (ob ^ (((ob >> 9) & 1) << 5)); }
__host__ __device__ __forceinline__ void stage_rc(int b, int& R, int& C) { const int st = b / 1024, sb = b % 1024, swz = sb ^ (((sb >> 9) & 1) << 5); R = (st >> 1) * 16 + swz / 64; C = (st & 1) * 32 + (swz % 64) / 2; }
__host__ __device__ __forceinline__ int perm32(int rho) { const int n = rho >> 4, i = rho & 15; return 8 * (i >> 2) + 4 * n + (i & 3); }

struct Unit { int pm, pn; };
struct Gemm { const bf16_t* A; const bf16_t* Bt; int M, N, K, lda; };

struct StaticOrder {
    int nM, nN, nwg, G, c;
    __host__ __device__ void init(int M, int N, int G_, int c_) { nM = M / BM; nN = N / BM; nwg = nM * nN; G = G_; c = c_; }
    __host__ __device__ bool next(int i, Unit& u) const {
        const long L = (long)i * G + c; if (L >= nwg) return false;
        int wgid = (int)L; { const int q = nwg / NXCD, r = nwg % NXCD, xcd = wgid % NXCD, off = wgid / NXCD; wgid = (xcd < r ? xcd * (q + 1) : r * (q + 1) + (xcd - r) * q) + off; }
        const int nig = WGM * nN, gid = wgid / nig, fm = gid * WGM, gsz = (nM - fm) < WGM ? (nM - fm) : WGM;
        u.pm = fm + ((wgid % nig) % gsz); u.pn = (wgid % nig) / gsz; return true;
    }
    __device__ __forceinline__ void a_ready(const Unit&) const {}
    __device__ __forceinline__ void done(const Unit&) const {}
};

__device__ __forceinline__ unsigned cvt_pk_bf16(float lo, float hi) { unsigned r; asm volatile("v_cvt_pk_bf16_f32 %0, %1, %2" : "=v"(r) : "v"(lo), "v"(hi)); return r; }
typedef float f32x2 __attribute__((ext_vector_type(2)));
__device__ __forceinline__ f32x2 gelu_pk(f32x2 v) {
    const f32x2 av = __builtin_elementwise_abs(v), d = av * 0.2316418882f + 1.0f;
    f32x2 t; t.x = __builtin_amdgcn_rcpf(d.x); t.y = __builtin_amdgcn_rcpf(d.y);
    f32x2 q = t * 0.5307027145f + (-0.7265760135f); q = q * t + 0.7107068705f; q = q * t + (-0.142248368f); q = q * t + 0.127414796f; q = q * t;
    const f32x2 s = (v * v) * (-0.72134752044f);
    f32x2 e; e.x = __builtin_amdgcn_exp2f(s.x); e.y = __builtin_amdgcn_exp2f(s.y);
    const f32x2 m = v * (q * e), r = v - m;
    f32x2 o; o.x = v.x < 0.f ? m.x : r.x; o.y = v.y < 0.f ? m.y : r.y; return o;
}
template <int ACT> struct EpiBf16 {
    static constexpr bool PERM = true, AFTER_DRAIN = false;
    bf16_t* O; int ldc; const float* bias;
    __device__ __forceinline__ void operator()(const f32x4 (&acc)[2][2][4][2], const Unit& u, int wr, int wc, int fr, int fq) const {
        const int row0 = u.pm * BM + wr * 64 + fr; const int col0 = u.pn * BM + wc * 32 + 8 * fq;
        f32x4 bv[2][2];
#pragma unroll
        for (int bj = 0; bj < 2; ++bj)
#pragma unroll
            for (int n = 0; n < 2; ++n) bv[bj][n] = bias ? *(const f32x4*)(bias + col0 + bj * HALF + 4 * n) : (f32x4){0.f, 0.f, 0.f, 0.f};
#pragma unroll
        for (int ai = 0; ai < 2; ++ai)
#pragma unroll
            for (int m = 0; m < 4; ++m) { bf16_t* rowp = O + (size_t)(row0 + ai * HALF + m * 16) * ldc + col0;
#pragma unroll
                for (int bj = 0; bj < 2; ++bj) { f32x4 v0 = acc[ai][bj][m][0] + bv[bj][0], v1 = acc[ai][bj][m][1] + bv[bj][1];
                    if (ACT == 1) { f32x2 a = gelu_pk((f32x2){v0[0], v0[1]}), b = gelu_pk((f32x2){v0[2], v0[3]}), c = gelu_pk((f32x2){v1[0], v1[1]}), d = gelu_pk((f32x2){v1[2], v1[3]});
                        v0 = (f32x4){a.x, a.y, b.x, b.y}; v1 = (f32x4){c.x, c.y, d.x, d.y}; }
                    if (ACT == 2) { v0 = __builtin_elementwise_max(v0, (f32x4){0.f, 0.f, 0.f, 0.f}); v1 = __builtin_elementwise_max(v1, (f32x4){0.f, 0.f, 0.f, 0.f}); v0 = v0 * v0; v1 = v1 * v1; }
                    u32x4 w; w.x = cvt_pk_bf16(v0[0], v0[1]); w.y = cvt_pk_bf16(v0[2], v0[3]); w.z = cvt_pk_bf16(v1[0], v1[1]); w.w = cvt_pk_bf16(v1[2], v1[3]);
                    *(u32x4*)(rowp + bj * HALF) = w; } }
    }
};
struct EpiResF32 {
    static constexpr bool PERM = false, AFTER_DRAIN = false;
    const float* base; float* out; int ldc; const float* bias; float alpha;
    __device__ __forceinline__ void operator()(const f32x4 (&acc)[2][2][4][2], const Unit& u, int wr, int wc, int fr, int fq) const {
        const int row0 = u.pm * BM + wr * 64 + fr, col0 = u.pn * BM + wc * 32 + 4 * fq;
        f32x4 bv[2][2];
#pragma unroll
        for (int bj = 0; bj < 2; ++bj)
#pragma unroll
            for (int n = 0; n < 2; ++n) bv[bj][n] = bias ? *(const f32x4*)(bias + col0 + bj * HALF + n * 16) : (f32x4){0.f, 0.f, 0.f, 0.f};
#pragma unroll
        for (int ai = 0; ai < 2; ++ai)
#pragma unroll
            for (int m = 0; m < 4; ++m) { const size_t off = (size_t)(row0 + ai * HALF + m * 16) * ldc + col0;
#pragma unroll
                for (int bj = 0; bj < 2; ++bj)
#pragma unroll
                    for (int n = 0; n < 2; ++n) { const f32x4 bs = *(const f32x4*)(base + off + bj * HALF + n * 16);
                        *(f32x4*)(out + off + bj * HALF + n * 16) = bs * alpha + acc[ai][bj][m][n] + bv[bj][n]; }
                if (m & 1) asm volatile("" ::: "memory"); }
    }
};
template <class Epi, class Sched, bool ALIGN_EPI = false, bool SP2 = false>
__device__ __forceinline__ void gemm_phase(PG8_LAS unsigned char* lds, const Gemm g, const Sched& S, const Epi& E) {
    int tid_l = threadIdx.x; asm volatile("" : "+v"(tid_l));
    const int tid = tid_l, wid = __builtin_amdgcn_readfirstlane(tid >> 6), lane = tid & 63, wr = wid >> 2, wc = wid & 3, fr = lane & 15, fq = lane >> 4;
    const int K = g.K, nt = K / BK;
    unsigned voffA[2], voffB[2];
#pragma unroll
    for (int i = 0; i < 2; ++i) { int R, C; stage_rc(tid * 16 + i * 8192, R, C); const int Rb = Epi::PERM ? ((R & ~31) + perm32(R & 31)) : R;
        voffA[i] = (unsigned)(R * g.lda + C) * 2u; voffB[i] = (unsigned)(Rb * K + C) * 2u; }
    const size_t kstep = (size_t)(BK * 2);
    const size_t hstepA = (size_t)HALF * g.lda * 2, hstepB = (size_t)HALF * K * 2;
    const size_t tstepA = 2 * hstepA, tstepB = 2 * hstepB;
    const unsigned ldsw = (unsigned)wid * 1024u;
    const int aoff = lds_byte(wr * 64 + fr, fq * 8), boff = lds_byte(wc * 32 + fr, fq * 8);
#define PG8_SA(b, h) (((b) * 2 + (h)) * HTB)
#define PG8_SB(b, h) ((4 + (b) * 2 + (h)) * HTB)
#define PG8_STAGE(bufoff, gbase, voff) do { _Pragma("unroll") for (int _i = 0; _i < 2; ++_i) \
        __builtin_amdgcn_global_load_lds((const unsigned*)((const char*)(gbase) + (voff)[_i]), (PG8_LAS unsigned*)(lds + (bufoff) + ldsw + _i * 8192), 16, 0, 0); } while (0)
#define PG8_LDA(dst, b, h) do { _Pragma("unroll") for (int m = 0; m < 4; ++m) _Pragma("unroll") for (int k = 0; k < 2; ++k) dst[m][k] = *(const PG8_LAS bf16x8*)(lds + PG8_SA(b, h) + aoff + m * 2048 + k * 1024); } while (0)
#define PG8_LDB(dst, b, h) do { _Pragma("unroll") for (int n = 0; n < 2; ++n) _Pragma("unroll") for (int k = 0; k < 2; ++k) dst[n][k] = *(const PG8_LAS bf16x8*)(lds + PG8_SB(b, h) + boff + n * 2048 + k * 1024); } while (0)
#define PG8_MMA(ai, bj, At, Bt) do { __builtin_amdgcn_s_setprio(1); _Pragma("unroll") for (int m = 0; m < 4; ++m) _Pragma("unroll") for (int n = 0; n < 2; ++n) _Pragma("unroll") for (int k = 0; k < 2; ++k) \
        acc[ai][bj][m][n] = __builtin_amdgcn_mfma_f32_16x16x32_bf16(Bt[n][k], At[m][k], acc[ai][bj][m][n], 0, 0, 0); __builtin_amdgcn_s_setprio(0); } while (0)
#define PG8_WAIT_V(n) asm volatile("s_waitcnt vmcnt(" #n ")" ::: "memory")
#define PG8_WAIT_L(n) asm volatile("s_waitcnt lgkmcnt(" #n ")" ::: "memory")
#define PG8_BAR __builtin_amdgcn_s_barrier()
#define PG8_SCHED __builtin_amdgcn_sched_barrier(0)
    Unit cur, nxt; int ui = 0;
    if (!S.next(0, cur)) return;
    f32x4 acc[2][2][4][2];
#pragma unroll
    for (int a = 0; a < 2; ++a)
#pragma unroll
        for (int b = 0; b < 2; ++b)
#pragma unroll
            for (int m = 0; m < 4; ++m)
#pragma unroll
                for (int n = 0; n < 2; ++n) acc[a][b][m][n] = (f32x4){0.f, 0.f, 0.f, 0.f};
    bf16x8 At[4][2], B0[2][2], B1[2][2];
    const char* cA = (const char*)g.A + (size_t)cur.pm * tstepA; const char* cB = (const char*)g.Bt + (size_t)cur.pn * tstepB;
    S.a_ready(cur);
    if constexpr (SP2) {
        PG8_STAGE(PG8_SB(0, 0), cB, voffB); PG8_STAGE(PG8_SB(0, 1), cB + hstepB, voffB); PG8_STAGE(PG8_SA(0, 0), cA, voffA); PG8_STAGE(PG8_SA(0, 1), cA + hstepA, voffA);
        if (wr == 1) PG8_BAR;
        PG8_WAIT_V(2); PG8_BAR;
        PG8_STAGE(PG8_SB(1, 0), cB + kstep, voffB); PG8_STAGE(PG8_SA(1, 0), cA + kstep, voffA); PG8_STAGE(PG8_SB(1, 1), cB + hstepB + kstep, voffB);
        PG8_WAIT_V(6); PG8_BAR;
    } else {
        PG8_STAGE(PG8_SB(0, 0), cB, voffB); PG8_STAGE(PG8_SA(0, 0), cA, voffA); PG8_STAGE(PG8_SB(0, 1), cB + hstepB, voffB); PG8_STAGE(PG8_SA(0, 1), cA + hstepA, voffA);
        if (wr == 1) PG8_BAR;
        PG8_WAIT_V(4); PG8_BAR;
        PG8_STAGE(PG8_SB(1, 0), cB + kstep, voffB); PG8_STAGE(PG8_SA(1, 0), cA + kstep, voffA); PG8_STAGE(PG8_SB(1, 1), cB + hstepB + kstep, voffB);
        PG8_WAIT_V(6); PG8_BAR;
    }
    for (;;) {
        const bool has_next = S.next(ui + 1, nxt);
        const char* nA = has_next ? (const char*)g.A + (size_t)nxt.pm * tstepA : cA; const char* nB = has_next ? (const char*)g.Bt + (size_t)nxt.pn * tstepB : cB;
        for (int t = 0; t < nt; t += 2) {
            const bool last = (t == nt - 2);
            const char* a1 = cA + (size_t)(t + 1) * kstep;
            const char* a2 = last ? nA : cA + (size_t)(t + 2) * kstep; const char* b2 = last ? nB : cB + (size_t)(t + 2) * kstep;
            const char* a3 = a2 + kstep; const char* b3 = b2 + kstep;
            if (last && has_next) S.a_ready(nxt);
            if constexpr (SP2) {
            PG8_LDB(B0, 0, 0); PG8_LDB(B1, 0, 1); PG8_SCHED; PG8_LDA(At, 0, 0); PG8_STAGE(PG8_SA(1, 1), a1 + hstepA, voffA);
            PG8_WAIT_V(8); PG8_WAIT_L(0); PG8_BAR; PG8_MMA(0, 0, At, B0); PG8_MMA(0, 1, At, B1); PG8_BAR; PG8_SCHED;
            PG8_LDA(At, 0, 1); PG8_STAGE(PG8_SB(0, 0), b2, voffB); PG8_STAGE(PG8_SB(0, 1), b2 + hstepB, voffB); PG8_STAGE(PG8_SA(0, 0), a2, voffA);
            PG8_WAIT_V(8); PG8_WAIT_L(0); PG8_BAR; PG8_MMA(1, 0, At, B0); PG8_MMA(1, 1, At, B1); PG8_BAR; PG8_SCHED;
            PG8_LDB(B0, 1, 0); PG8_LDB(B1, 1, 1); PG8_SCHED; PG8_LDA(At, 1, 0); PG8_STAGE(PG8_SA(0, 1), a2 + hstepA, voffA);
            PG8_WAIT_V(8); PG8_WAIT_L(0); PG8_BAR; PG8_MMA(0, 0, At, B0); PG8_MMA(0, 1, At, B1); PG8_BAR; PG8_SCHED;
            PG8_LDA(At, 1, 1); PG8_STAGE(PG8_SB(1, 0), b3, voffB); PG8_STAGE(PG8_SB(1, 1), b3 + hstepB, voffB); PG8_STAGE(PG8_SA(1, 0), a3, voffA);
            PG8_WAIT_V(8); PG8_WAIT_L(0); PG8_BAR; PG8_MMA(1, 0, At, B0); PG8_MMA(1, 1, At, B1); PG8_BAR; PG8_SCHED;
            } else {
            PG8_LDB(B0, 0, 0); PG8_SCHED; PG8_LDA(At, 0, 0); PG8_STAGE(PG8_SA(1, 1), a1 + hstepA, voffA);
            PG8_WAIT_L(8); PG8_BAR; PG8_WAIT_L(0); PG8_MMA(0, 0, At, B0); PG8_BAR; PG8_SCHED;
            PG8_LDB(B1, 0, 1); PG8_STAGE(PG8_SB(0, 0), b2, voffB);
            PG8_BAR; PG8_WAIT_L(0); PG8_MMA(0, 1, At, B1); PG8_BAR;
            PG8_LDA(At, 0, 1); PG8_STAGE(PG8_SA(0, 0), a2, voffA);
            PG8_BAR; PG8_WAIT_L(0); PG8_MMA(1, 0, At, B0); PG8_BAR; PG8_SCHED;
            PG8_STAGE(PG8_SB(0, 1), b2 + hstepB, voffB);
            PG8_WAIT_V(6); PG8_BAR; PG8_MMA(1, 1, At, B1); PG8_BAR;
            PG8_LDB(B0, 1, 0); PG8_SCHED; PG8_LDA(At, 1, 0); PG8_STAGE(PG8_SA(0, 1), a2 + hstepA, voffA);
            PG8_WAIT_L(8); PG8_BAR; PG8_WAIT_L(0); PG8_MMA(0, 0, At, B0); PG8_BAR; PG8_SCHED;
            PG8_LDB(B1, 1, 1); PG8_STAGE(PG8_SB(1, 0), b3, voffB);
            PG8_BAR; PG8_WAIT_L(0); PG8_MMA(0, 1, At, B1); PG8_BAR;
            PG8_LDA(At, 1, 1); PG8_STAGE(PG8_SA(1, 0), a3, voffA);
            PG8_BAR; PG8_WAIT_L(0); PG8_MMA(1, 0, At, B0); PG8_BAR; PG8_SCHED;
            PG8_STAGE(PG8_SB(1, 1), b3 + hstepB, voffB);
            PG8_WAIT_V(6); PG8_BAR; PG8_MMA(1, 1, At, B1); PG8_BAR;
            }
        }
        if constexpr (ALIGN_EPI) { if (wr == 0) PG8_BAR; }
        if constexpr (!Epi::AFTER_DRAIN) { E(acc, cur, wr, wc, fr, fq); S.done(cur); }
        if (!has_next) break;
#pragma unroll
        for (int a = 0; a < 2; ++a)
#pragma unroll
            for (int b = 0; b < 2; ++b)
#pragma unroll
                for (int m = 0; m < 4; ++m)
#pragma unroll
                    for (int n = 0; n < 2; ++n) acc[a][b][m][n] = (f32x4){0.f, 0.f, 0.f, 0.f};
        cur = nxt; cA = nA; cB = nB; ++ui;
        if constexpr (ALIGN_EPI) { if (wr == 1) PG8_BAR; }
    }
    PG8_WAIT_V(0);
    if constexpr (!ALIGN_EPI) { if (wr == 0) PG8_BAR; }
    PG8_BAR;
    if constexpr (Epi::AFTER_DRAIN) { E.fused(acc, cur, wr, wc, fr, fq, lds, wid, lane); S.done(cur); }
#undef PG8_SA
#undef PG8_SB
#undef PG8_STAGE
#undef PG8_LDA
#undef PG8_LDB
#undef PG8_MMA
#undef PG8_WAIT_V
#undef PG8_WAIT_L
#undef PG8_BAR
#undef PG8_SCHED
}
}

#ifndef PG8_SP2
#define PG8_SP2 true
#endif
#ifndef PG8_ALIGN
#define PG8_ALIGN true
#endif

constexpr int NWAVES = 8;
constexpr int D = 1024, BATCH = 8, SEQ = 2048, M = BATCH * SEQ, DG = 2048, NH = 2 * DG, NGRP = 8, GDIM = 256, GBLK = 128, FF = 4096;
constexpr float LN_EPS = 1e-5f, ALPHA = 1.4142135623730951f;
constexpr size_t MiB = 1u << 20;
constexpr size_t WS_CTL = 0, CTL_ZERO_BYTES = 1 * MiB;
constexpr size_t WS_WSM = 1 * MiB;
constexpr size_t WS_VST = 2 * MiB;
constexpr size_t WS_WAIN = 8 * MiB, WS_WAOUT = 16 * MiB, WS_WBIN = 20 * MiB, WS_WBOUT = 26 * MiB, WS_W1 = 28 * MiB, WS_W2 = 44 * MiB;
constexpr size_t WS_XN = 64 * MiB;
constexpr size_t WS_H = 96 * MiB;
constexpr size_t WS_END = 224 * MiB;
constexpr int LDS_BYTES = 147456;

#define GAS __attribute__((address_space(1)))
#define LAS __attribute__((address_space(3)))
typedef unsigned short bf16;
typedef unsigned v4u __attribute__((ext_vector_type(4)));
typedef unsigned v2u __attribute__((ext_vector_type(2)));
typedef float f32x4 __attribute__((ext_vector_type(4)));
typedef short bf16x8 __attribute__((ext_vector_type(8)));
#define LDS_WAIT() asm volatile("s_waitcnt lgkmcnt(0)" ::: "memory")
__device__ __forceinline__ unsigned pk2(float lo, float hi) { return pg8::cvt_pk_bf16(lo, hi); }
__device__ __forceinline__ float bflo(unsigned w) { return __uint_as_float(w << 16); }
__device__ __forceinline__ float bfhi(unsigned w) { return __uint_as_float(w & 0xffff0000u); }
__device__ __forceinline__ float wave_sum(float v) {
#pragma unroll
    for (int o = 1; o < 64; o <<= 1) v += __shfl_xor(v, o);
    return v;
}

__device__ __forceinline__ void p0_transpose_item(const float* W, int K, int N, bf16* WT, LAS float* scr, int item, int lane) {
    const int nblk = N / 32, kb = item / nblk, nb = item % nblk, k0 = 64 * kb, n0 = 32 * nb;
#pragma unroll 8
    for (int i = 0; i < 32; ++i) { const int kk = 2 * i + (lane >> 5); scr[kk * 33 + (lane & 31)] = W[(size_t)(k0 + kk) * N + n0 + (lane & 31)]; }
    LDS_WAIT(); asm volatile("" ::: "memory");
    const int c = lane & 7;
#pragma unroll
    for (int j = 0; j < 4; ++j) { const int n = (lane >> 3) + 8 * j; const LAS float* s = scr + (8 * c) * 33 + n;
        v4u o; o.x = pk2(s[0 * 33], s[1 * 33]); o.y = pk2(s[2 * 33], s[3 * 33]); o.z = pk2(s[4 * 33], s[5 * 33]); o.w = pk2(s[6 * 33], s[7 * 33]);
        *(v4u*)(WT + (size_t)(n0 + n) * K + k0 + 8 * c) = o; }
    LDS_WAIT(); asm volatile("" ::: "memory");
}

struct Args { const float* in[16]; float* out; unsigned char* ws; };

__device__ __forceinline__ void ln_rows(float* X, bf16* XN, const float* g, const float* b, int gw, int NGW, int lane) {
    f32x4 gv[4], bv[4];
#pragma unroll
    for (int j = 0; j < 4; ++j) { gv[j] = ((const f32x4*)g)[lane + 64 * j]; bv[j] = ((const f32x4*)b)[lane + 64 * j]; }
    for (int m = gw; m < M; m += NGW) {
        f32x4* xr = (f32x4*)(X + (size_t)m * D) + lane;
        f32x4 v[4]; float s = 0.f;
#pragma unroll
        for (int j = 0; j < 4; ++j) { v[j] = xr[64 * j]; s += (v[j].x + v[j].y) + (v[j].z + v[j].w); }
        const float mean = wave_sum(s) * (1.f / D); float s2 = 0.f;
#pragma unroll
        for (int j = 0; j < 4; ++j) { v[j] = v[j] - mean; s2 += (v[j].x * v[j].x + v[j].y * v[j].y) + (v[j].z * v[j].z + v[j].w * v[j].w); }
        const float rstd = 1.f / sqrtf(wave_sum(s2) * (1.f / D) + LN_EPS);
        v2u* o8 = (v2u*)(XN + (size_t)m * D) + lane;
#pragma unroll
        for (int j = 0; j < 4; ++j) { const f32x4 y = v[j] * rstd * gv[j] + bv[j]; xr[64 * j] = y; v2u w; w.x = pk2(y.x, y.y); w.y = pk2(y.z, y.w); o8[64 * j] = w; }
    }
}

__global__ void __launch_bounds__(NWAVES * 64, 2) fwd_kernel(Args args) {
    extern __shared__ __attribute__((aligned(16))) unsigned char lds_raw[];
    cg::grid_group grid = cg::this_grid();
    LAS unsigned char* lds = (LAS unsigned char*)lds_raw;
#define PHASE_IDS() int tid_l = threadIdx.x; asm volatile("" : "+v"(tid_l)); const int tid = tid_l, lane = tid & 63, wave = __builtin_amdgcn_readfirstlane(tid >> 6), gw = bid * NWAVES + wave; (void)lane; (void)gw
    const int G = gridDim.x, bid = blockIdx.x, NGW = G * NWAVES;
    unsigned char* ws = args.ws;
    const float* x = args.in[0]; const float* ln_g = args.in[1]; const float* ln_b = args.in[2];
    const float* a_w_in = args.in[3]; const float* a_b_in = args.in[4]; const float* a_v_g = args.in[5]; const float* a_v_b = args.in[6];
    const float* a_w_s = args.in[7]; const float* a_b_s = args.in[8]; const float* a_w_out = args.in[9]; const float* a_b_out = args.in[10];
    const float* b_w_in = args.in[11]; const float* b_conv = args.in[12]; const float* b_w_out = args.in[13];
    const float* mlp_w1 = args.in[14]; const float* mlp_w2 = args.in[15];
    float* out = args.out;
    bf16* WSM = (bf16*)(ws + WS_WSM); float* VST = (float*)(ws + WS_VST);
    bf16* WAIN = (bf16*)(ws + WS_WAIN); bf16* WAOUT = (bf16*)(ws + WS_WAOUT); bf16* WBIN = (bf16*)(ws + WS_WBIN); bf16* WBOUT = (bf16*)(ws + WS_WBOUT);
    bf16* W1T = (bf16*)(ws + WS_W1); bf16* W2T = (bf16*)(ws + WS_W2);
    bf16* XN = (bf16*)(ws + WS_XN); bf16* H = (bf16*)(ws + WS_H);

    {
        PHASE_IDS();
        LAS float* scr = (LAS float*)(lds + wave * 16384);
        constexpr int I_AIN = (D / 64) * (NH / 32), I_AOUT = (DG / 64) * (D / 32), I_BIN = (D / 64) * (3 * D / 32), I_BOUT = (D / 64) * (D / 32), I_W1 = (D / 64) * (FF / 32), I_W2 = (FF / 64) * (D / 32);
        constexpr int NITEMS = I_AIN + I_AOUT + I_BIN + I_BOUT + 2 * I_W1 + 2 * I_W2;
        for (int it = gw; it < NITEMS; it += NGW) {
            int r = it;
            if (r < I_AIN) { p0_transpose_item(a_w_in, D, NH, WAIN, scr, r, lane); continue; } r -= I_AIN;
            if (r < I_AOUT) { p0_transpose_item(a_w_out, DG, D, WAOUT, scr, r, lane); continue; } r -= I_AOUT;
            if (r < I_BIN) { p0_transpose_item(b_w_in, D, 3 * D, WBIN, scr, r, lane); continue; } r -= I_BIN;
            if (r < I_BOUT) { p0_transpose_item(b_w_out, D, D, WBOUT, scr, r, lane); continue; } r -= I_BOUT;
            if (r < 2 * I_W1) { const int l = r / I_W1; p0_transpose_item(mlp_w1 + (size_t)l * D * FF, D, FF, W1T + (size_t)l * D * FF, scr, r % I_W1, lane); continue; } r -= 2 * I_W1;
            { const int l = r / I_W2; p0_transpose_item(mlp_w2 + (size_t)l * D * FF, FF, D, W2T + (size_t)l * D * FF, scr, r % I_W2, lane); }
        }
        for (int m = gw; m < M; m += NGW) {
            const f32x4* xr = (const f32x4*)(x + (size_t)m * D) + lane; v2u* o8 = (v2u*)(XN + (size_t)m * D) + lane;
#pragma unroll
            for (int j = 0; j < 4; ++j) { const f32x4 v = xr[64 * j]; v2u w; w.x = pk2(v.x, v.y); w.y = pk2(v.z, v.w); o8[64 * j] = w; }
        }
        for (int i = (bid * 512 + tid) * 4; i < NGRP * GBLK * GBLK; i += G * 512 * 4) {
            const int t = (i >> 7) & 127, s = i & 127; f32x4 v = *(const f32x4*)(a_w_s + i);
            if (t < 64 && s >= 64) v = (f32x4){0.f, 0.f, 0.f, 0.f};
            v2u w; w.x = pk2(v.x, v.y); w.y = pk2(v.z, v.w); *(v2u*)(WSM + i) = w;
        }
    }
    grid.sync();

#pragma unroll 1
    for (int layer = 0; layer < 2; ++layer) {
        pg8::Gemm gmix; const float* mixbias; const float* xin;
        if (layer == 0) {
            { pg8::Gemm g{XN, WAIN, M, NH, D, D}; pg8::StaticOrder S; S.init(M, NH, G, bid); pg8::EpiBf16<1> E{H, NH, a_b_in};
              pg8::gemm_phase<pg8::EpiBf16<1>, pg8::StaticOrder, PG8_ALIGN, PG8_SP2>(lds, g, S, E); }
            grid.sync();
            { PHASE_IDS();
            for (int m = gw; m < M; m += NGW) {
                const v4u* vr = (const v4u*)(H + (size_t)m * NH + DG) + lane; v4u r[4]; float s = 0.f;
#pragma unroll
                for (int j = 0; j < 4; ++j) { r[j] = vr[64 * j]; s += (bflo(r[j].x) + bfhi(r[j].x)) + (bflo(r[j].y) + bfhi(r[j].y)) + (bflo(r[j].z) + bfhi(r[j].z)) + (bflo(r[j].w) + bfhi(r[j].w)); }
                const float mean = wave_sum(s) * (1.f / DG); float q = 0.f;
#pragma unroll
                for (int j = 0; j < 4; ++j) {
#pragma unroll
                    for (int e = 0; e < 4; ++e) { const float a = bflo(r[j][e]) - mean, b = bfhi(r[j][e]) - mean; q += a * a + b * b; } }
                const float rstd = 1.f / sqrtf(wave_sum(q) * (1.f / DG) + LN_EPS);
                if (lane == 0) { VST[2 * m] = mean; VST[2 * m + 1] = rstd; }
            } }
            grid.sync();
            {
                PHASE_IDS();
                LAS bf16* WA = (LAS bf16*)lds;
                LAS bf16* VT = (LAS bf16*)(lds + 34816);
                const int wr = wave >> 2, wc = wave & 3, fr = lane & 15, fq = lane >> 4;
                for (int item = bid; item < (M / GBLK) * NGRP; item += G) {
                    const int nb = item >> 3, g = item & 7, row0 = nb * GBLK;
                    __syncthreads();
#pragma unroll
                    for (int i = 0; i < 4; ++i) { const int ch = tid + i * 512, t = ch >> 4, sc = ch & 15;
                        const v4u w = *(const v4u*)(WSM + (size_t)(g * GBLK + t) * GBLK + sc * 8); *(LAS v4u*)(WA + t * 136 + sc * 8) = w; }
                    v4u raw[2][4]; float mu[2], rs[2];
#pragma unroll
                    for (int h = 0; h < 2; ++h) { const int s = lane + 64 * h; mu[h] = VST[2 * (row0 + s)]; rs[h] = VST[2 * (row0 + s) + 1];
#pragma unroll
                        for (int j = 0; j < 4; ++j) raw[h][j] = *(const v4u*)(H + (size_t)(row0 + s) * NH + DG + g * GDIM + (wave * 4 + j) * 8); }
#pragma unroll
                    for (int j = 0; j < 4; ++j) { const int c0 = (wave * 4 + j) * 8;
                        const f32x4 g0 = *(const f32x4*)(a_v_g + g * GDIM + c0), g1 = *(const f32x4*)(a_v_g + g * GDIM + c0 + 4);
                        const f32x4 b0 = *(const f32x4*)(a_v_b + g * GDIM + c0), b1 = *(const f32x4*)(a_v_b + g * GDIM + c0 + 4);
#pragma unroll
                        for (int h = 0; h < 2; ++h) { const int s = lane + 64 * h; const v4u r = raw[h][j]; LAS bf16* dst = VT + c0 * 136 + s;
                            float y[8];
                            y[0] = (bflo(r.x) - mu[h]) * rs[h] * g0.x + b0.x; y[1] = (bfhi(r.x) - mu[h]) * rs[h] * g0.y + b0.y;
                            y[2] = (bflo(r.y) - mu[h]) * rs[h] * g0.z + b0.z; y[3] = (bfhi(r.y) - mu[h]) * rs[h] * g0.w + b0.w;
                            y[4] = (bflo(r.z) - mu[h]) * rs[h] * g1.x + b1.x; y[5] = (bfhi(r.z) - mu[h]) * rs[h] * g1.y + b1.y;
                            y[6] = (bflo(r.w) - mu[h]) * rs[h] * g1.z + b1.z; y[7] = (bfhi(r.w) - mu[h]) * rs[h] * g1.w + b1.w;
#pragma unroll
                            for (int e = 0; e < 8; e += 2) { const unsigned p = pk2(y[e], y[e + 1]); dst[e * 136] = (bf16)(p & 0xffffu); dst[(e + 1) * 136] = (bf16)(p >> 16); } } }
                    __syncthreads();
                    f32x4 acc[4][4];
#pragma unroll
                    for (int m = 0; m < 4; ++m)
#pragma unroll
                        for (int n = 0; n < 4; ++n) acc[m][n] = (f32x4){0.f, 0.f, 0.f, 0.f};
#pragma unroll
                    for (int kk = 0; kk < 4; ++kk) {
                        bf16x8 af[4], bfr[4];
#pragma unroll
                        for (int m = 0; m < 4; ++m) af[m] = *(const LAS bf16x8*)(WA + (wr * 64 + m * 16 + fr) * 136 + kk * 32 + fq * 8);
#pragma unroll
                        for (int n = 0; n < 4; ++n) bfr[n] = *(const LAS bf16x8*)(VT + (wc * 64 + (n >> 1) * 32 + 8 * (fr >> 2) + 4 * (n & 1) + (fr & 3)) * 136 + kk * 32 + fq * 8);
#pragma unroll
                        for (int m = 0; m < 4; ++m)
#pragma unroll
                            for (int n = 0; n < 4; ++n) acc[m][n] = __builtin_amdgcn_mfma_f32_16x16x32_bf16(bfr[n], af[m], acc[m][n], 0, 0, 0);
                    }
#pragma unroll
                    for (int m = 0; m < 4; ++m) { const int t = wr * 64 + m * 16 + fr; const float bs = a_b_s[g * GBLK + t];
#pragma unroll
                        for (int p = 0; p < 2; ++p) { bf16* up = H + (size_t)(row0 + t) * NH + g * GDIM + wc * 64 + p * 32 + 8 * fq;
                            const v4u uu = *(const v4u*)up; const f32x4 a0 = acc[m][2 * p] + bs, a1 = acc[m][2 * p + 1] + bs; v4u o;
                            o.x = pk2(bflo(uu.x) * a0.x, bfhi(uu.x) * a0.y); o.y = pk2(bflo(uu.y) * a0.z, bfhi(uu.y) * a0.w);
                            o.z = pk2(bflo(uu.z) * a1.x, bfhi(uu.z) * a1.y); o.w = pk2(bflo(uu.w) * a1.z, bfhi(uu.w) * a1.w);
                            *(v4u*)up = o; } }
                }
                __syncthreads();
            }
            gmix = pg8::Gemm{H, WAOUT, M, D, DG, NH}; mixbias = a_b_out; xin = x;
        } else {
            { pg8::Gemm g{XN, WBIN, M, 3 * D, D, D}; pg8::StaticOrder S; S.init(M, 3 * D, G, bid); pg8::EpiBf16<0> E{H, 3 * D, nullptr};
              pg8::gemm_phase<pg8::EpiBf16<0>, pg8::StaticOrder, PG8_ALIGN, PG8_SP2>(lds, g, S, E); }
            grid.sync();
            {
                PHASE_IDS();
                const int cgp = tid & 127, rsub = tid >> 7, ch = cgp * 8;
                float w0[8], w1[8], w2[8];
#pragma unroll
                for (int e = 0; e < 8; ++e) { w0[e] = b_conv[ch + e]; w1[e] = b_conv[D + ch + e]; w2[e] = b_conv[2 * D + ch + e]; }
                for (int it = bid; it < M / 64; it += G) {
                    const int t0 = it * 64 + rsub * 16; float p1[8], p2[8];
                    if ((t0 % SEQ) == 0) {
#pragma unroll
                        for (int e = 0; e < 8; ++e) { p1[e] = 0.f; p2[e] = 0.f; }
                    } else {
                        const v4u c2 = *(const v4u*)(H + (size_t)(t0 - 2) * (3 * D) + D + ch), h2 = *(const v4u*)(H + (size_t)(t0 - 2) * (3 * D) + 2 * D + ch);
                        const v4u c1 = *(const v4u*)(H + (size_t)(t0 - 1) * (3 * D) + D + ch), h1 = *(const v4u*)(H + (size_t)(t0 - 1) * (3 * D) + 2 * D + ch);
#pragma unroll
                        for (int e = 0; e < 4; ++e) { p2[2 * e] = bflo(c2[e]) * bflo(h2[e]); p2[2 * e + 1] = bfhi(c2[e]) * bfhi(h2[e]); p1[2 * e] = bflo(c1[e]) * bflo(h1[e]); p1[2 * e + 1] = bfhi(c1[e]) * bfhi(h1[e]); }
                    }
#pragma unroll 4
                    for (int r = 0; r < 16; ++r) {
                        bf16* bp = H + (size_t)(t0 + r) * (3 * D) + ch;
                        const v4u bb = *(const v4u*)bp, cc = *(const v4u*)(bp + D), hh = *(const v4u*)(bp + 2 * D); v4u o;
#pragma unroll
                        for (int e = 0; e < 4; ++e) {
                            const float q0 = bflo(cc[e]) * bflo(hh[e]), q1 = bfhi(cc[e]) * bfhi(hh[e]);
                            const float o0 = bflo(bb[e]) * (w0[2 * e] * p2[2 * e] + w1[2 * e] * p1[2 * e] + w2[2 * e] * q0);
                            const float o1 = bfhi(bb[e]) * (w0[2 * e + 1] * p2[2 * e + 1] + w1[2 * e + 1] * p1[2 * e + 1] + w2[2 * e + 1] * q1);
                            o[e] = pk2(o0, o1); p2[2 * e] = p1[2 * e]; p2[2 * e + 1] = p1[2 * e + 1]; p1[2 * e] = q0; p1[2 * e + 1] = q1;
                        }
                        *(v4u*)bp = o;
                    }
                }
            }
            gmix = pg8::Gemm{H, WBOUT, M, D, D, 3 * D}; mixbias = nullptr; xin = out;
        }
        grid.sync();
        { pg8::StaticOrder S; S.init(M, D, G, bid); pg8::EpiResF32 E{xin, out, D, mixbias, ALPHA};
          pg8::gemm_phase<pg8::EpiResF32, pg8::StaticOrder, PG8_ALIGN, PG8_SP2>(lds, gmix, S, E); }
        grid.sync();
        { PHASE_IDS(); ln_rows(out, XN, ln_g + (size_t)(layer * 2 + 0) * D, ln_b + (size_t)(layer * 2 + 0) * D, gw, NGW, lane); }
        grid.sync();
        { pg8::Gemm g{XN, W1T + (size_t)layer * D * FF, M, FF, D, D}; pg8::StaticOrder S; S.init(M, FF, G, bid); pg8::EpiBf16<2> E{H, FF, nullptr};
          pg8::gemm_phase<pg8::EpiBf16<2>, pg8::StaticOrder, PG8_ALIGN, PG8_SP2>(lds, g, S, E); }
        grid.sync();
        { pg8::Gemm g{H, W2T + (size_t)layer * D * FF, M, D, FF, FF}; pg8::StaticOrder S; S.init(M, D, G, bid); pg8::EpiResF32 E{out, out, D, nullptr, ALPHA};
          pg8::gemm_phase<pg8::EpiResF32, pg8::StaticOrder, PG8_ALIGN, PG8_SP2>(lds, g, S, E); }
        grid.sync();
        { PHASE_IDS(); ln_rows(out, XN, ln_g + (size_t)(layer * 2 + 1) * D, ln_b + (size_t)(layer * 2 + 1) * D, gw, NGW, lane); }
        if (layer == 0) grid.sync();
    }
}

extern "C" void kernel_launch(void* const* d_in, const int* in_sizes, int n_in, void* d_out, int out_size, void* d_ws, size_t ws_size, hipStream_t stream) {
    static int grid = 0;
    if (grid == 0) {
        if (n_in != 16 || in_sizes[0] != M * D || out_size != M * D || ws_size < WS_END) { fprintf(stderr, "kernel_launch: unexpected shapes (n_in %d, in0 %d, out %d, ws %zu)\n", n_in, n_in > 0 ? in_sizes[0] : -1, out_size, ws_size); grid = -1; return; }
        int dev = 0, cus = 0, per_cu = 0;
        if (hipGetDevice(&dev) != hipSuccess || hipDeviceGetAttribute(&cus, hipDeviceAttributeMultiprocessorCount, dev) != hipSuccess) { grid = -1; return; }
        if (hipFuncSetAttribute((const void*)fwd_kernel, hipFuncAttributeMaxDynamicSharedMemorySize, LDS_BYTES) != hipSuccess) { fprintf(stderr, "kernel_launch: hipFuncSetAttribute failed\n"); grid = -1; return; }
        if (hipOccupancyMaxActiveBlocksPerMultiprocessor(&per_cu, (const void*)fwd_kernel, NWAVES * 64, LDS_BYTES) != hipSuccess || per_cu < 1) { fprintf(stderr, "kernel_launch: occupancy query reports %d\n", per_cu); (void)hipGetLastError(); grid = -1; return; }
        grid = cus;
        fprintf(stderr, "kernel_launch: cus %d per_cu %d grid %d\n", cus, per_cu, grid);
    }
    if (grid < 0) return;
    Args a{};
    for (int i = 0; i < 16; ++i) a.in[i] = (const float*)d_in[i];
    a.out = (float*)d_out; a.ws = (unsigned char*)d_ws;
    void* kargs[] = {&a};
    const hipError_t e = hipLaunchCooperativeKernel((const void*)fwd_kernel, dim3(grid), dim3(NWAVES * 64), kargs, LDS_BYTES, stream);
    if (e != hipSuccess) fprintf(stderr, "kernel_launch: cooperative launch failed: %s (grid %d)\n", hipGetErrorString(e), grid);
}
```

```cpp
#include <hip/hip_runtime.h>
#include <hip/hip_cooperative_groups.h>
#include <cstdio>
#include <cstdint>
namespace cg = cooperative_groups;
namespace pg8 {
#define PG8_LAS __attribute__((address_space(3)))
typedef unsigned short bf16_t;
typedef short bf16x8 __attribute__((ext_vector_type(8)));
typedef float f32x4 __attribute__((ext_vector_type(4)));
typedef unsigned u32x4 __attribute__((ext_vector_type(4)));
constexpr int BM = 256, BK = 64, HALF = 128, HTB = HALF * BK * 2  , STAGE_BYTES = 8 * HTB, NXCD = 8, WGM = 8;

__host__ __device__ __forceinline__ int lds_byte(int r, int c) { const int st = (r >> 4) * 2 + (c >> 5), rr = r & 15, cc = c & 31, ob = rr * 64 + cc * 2; return st * 1024 + (ob ^ (((ob >> 9) & 1) << 5)); }
__host__ __device__ __forceinline__ void stage_rc(int b, int& R, int& C) { const int st = b / 1024, sb = b % 1024, swz = sb ^ (((sb >> 9) & 1) << 5); R = (st >> 1) * 16 + swz / 64; C = (st & 1) * 32 + (swz % 64) / 2; }
__host__ __device__ __forceinline__ int perm32(int rho) { const int n = rho >> 4, i = rho & 15; return 8 * (i >> 2) + 4 * n + (i & 3); }

struct Unit { int pm, pn; };
struct Gemm { const bf16_t* A; const bf16_t* Bt; int M, N, K, lda; };

struct StaticOrder {
    int nM, nN, nwg, G, c;
    __host__ __device__ void init(int M, int N, int G_, int c_) { nM = M / BM; nN = N / BM; nwg = nM * nN; G = G_; c = c_; }
    __host__ __device__ bool next(int i, Unit& u) const {
        const long L = (long)i * G + c; if (L >= nwg) return false;
        int wgid = (int)L; { const int q = nwg / NXCD, r = nwg % NXCD, xcd = wgid % NXCD, off = wgid / NXCD; wgid = (xcd < r ? xcd * (q + 1) : r * (q + 1) + (xcd - r) * q) + off; }
        const int nig = WGM * nN, gid = wgid / nig, fm = gid * WGM, gsz = (nM - fm) < WGM ? (nM - fm) : WGM;
        u.pm = fm + ((wgid % nig) % gsz); u.pn = (wgid % nig) / gsz; return true;
    }
    __device__ __forceinline__ void a_ready(const Unit&) const {}
    __device__ __forceinline__ void done(const Unit&) const {}
};

__device__ __forceinline__ unsigned cvt_pk_bf16(float lo, float hi) { unsigned r; asm volatile("v_cvt_pk_bf16_f32 %0, %1, %2" : "=v"(r) : "v"(lo), "v"(hi)); return r; }
typedef float f32x2 __attribute__((ext_vector_type(2)));
__device__ __forceinline__ f32x2 gelu_pk(f32x2 v) {
    const f32x2 av = __builtin_elementwise_abs(v), d = av * 0.2316418882f + 1.0f;
    f32x2 t; t.x = __builtin_amdgcn_rcpf(d.x); t.y = __builtin_amdgcn_rcpf(d.y);
    f32x2 q = t * 0.5307027145f + (-0.7265760135f); q = q * t + 0.7107068705f; q = q * t + (-0.142248368f); q = q * t + 0.127414796f; q = q * t;
    const f32x2 s = (v * v) * (-0.72134752044f);
    f32x2 e; e.x = __builtin_amdgcn_exp2f(s.x); e.y = __builtin_amdgcn_exp2f(s.y);
    const f32x2 m = v * (q * e), r = v - m;
    f32x2 o; o.x = v.x < 0.f ? m.x : r.x; o.y = v.y < 0.f ? m.y : r.y; return o;
}
template <int ACT> struct EpiBf16 {
    static constexpr bool PERM = true, AFTER_DRAIN = false;
    bf16_t* O; int ldc; const float* bias;
    __device__ __forceinline__ void operator()(const f32x4 (&acc)[2][2][4][2], const Unit& u, int wr, int wc, int fr, int fq) const {
        const int row0 = u.pm * BM + wr * 64 + fr; const int col0 = u.pn * BM + wc * 32 + 8 * fq;
        f32x4 bv[2][2];
#pragma unroll
        for (int bj = 0; bj < 2; ++bj)
#pragma unroll
            for (int n = 0; n < 2; ++n) bv[bj][n] = bias ? *(const f32x4*)(bias + col0 + bj * HALF + 4 * n) : (f32x4){0.f, 0.f, 0.f, 0.f};
#pragma unroll
        for (int ai = 0; ai < 2; ++ai)
#pragma unroll
            for (int m = 0; m < 4; ++m) { bf16_t* rowp = O + (size_t)(row0 + ai * HALF + m * 16) * ldc + col0;
#pragma unroll
                for (int bj = 0; bj < 2; ++bj) { f32x4 v0 = acc[ai][bj][m][0] + bv[bj][0], v1 = acc[ai][bj][m][1] + bv[bj][1];
                    if (ACT == 1) { f32x2 a = gelu_pk((f32x2){v0[0], v0[1]}), b = gelu_pk((f32x2){v0[2], v0[3]}), c = gelu_pk((f32x2){v1[0], v1[1]}), d = gelu_pk((f32x2){v1[2], v1[3]});
                        v0 = (f32x4){a.x, a.y, b.x, b.y}; v1 = (f32x4){c.x, c.y, d.x, d.y}; }
                    if (ACT == 2) { v0 = __builtin_elementwise_max(v0, (f32x4){0.f, 0.f, 0.f, 0.f}); v1 = __builtin_elementwise_max(v1, (f32x4){0.f, 0.f, 0.f, 0.f}); v0 = v0 * v0; v1 = v1 * v1; }
                    u32x4 w; w.x = cvt_pk_bf16(v0[0], v0[1]); w.y = cvt_pk_bf16(v0[2], v0[3]); w.z = cvt_pk_bf16(v1[0], v1[1]); w.w = cvt_pk_bf16(v1[2], v1[3]);
                    *(u32x4*)(rowp + bj * HALF) = w; } }
    }
};
struct EpiResF32 {
    static constexpr bool PERM = false, AFTER_DRAIN = false;
    const float* base; float* out; int ldc; const float* bias; float alpha;
    __device__ __forceinline__ void operator()(const f32x4 (&acc)[2][2][4][2], const Unit& u, int wr, int wc, int fr, int fq) const {
        const int row0 = u.pm * BM + wr * 64 + fr, col0 = u.pn * BM + wc * 32 + 4 * fq;
        f32x4 bv[2][2];
#pragma unroll
        for (int bj = 0; bj < 2; ++bj)
#pragma unroll
            for (int n = 0; n < 2; ++n) bv[bj][n] = bias ? *(const f32x4*)(bias + col0 + bj * HALF + n * 16) : (f32x4){0.f, 0.f, 0.f, 0.f};
#pragma unroll
        for (int ai = 0; ai < 2; ++ai)
#pragma unroll
            for (int m = 0; m < 4; ++m) { const size_t off = (size_t)(row0 + ai * HALF + m * 16) * ldc + col0;
#pragma unroll
                for (int bj = 0; bj < 2; ++bj)
#pragma unroll
                    for (int n = 0; n < 2; ++n) { const f32x4 bs = *(const f32x4*)(base + off + bj * HALF + n * 16);
                        *(f32x4*)(out + off + bj * HALF + n * 16) = bs * alpha + acc[ai][bj][m][n] + bv[bj][n]; }
                if (m & 1) asm volatile("" ::: "memory"); }
    }
};
template <class Epi, class Sched, bool ALIGN_EPI = false, bool SP2 = false>
__device__ __forceinline__ void gemm_phase(PG8_LAS unsigned char* lds, const Gemm g, const Sched& S, const Epi& E) {
    int tid_l = threadIdx.x; asm volatile("" : "+v"(tid_l));
    const int tid = tid_l, wid = __builtin_amdgcn_readfirstlane(tid >> 6), lane = tid & 63, wr = wid >> 2, wc = wid & 3, fr = lane & 15, fq = lane >> 4;
    const int K = g.K, nt = K / BK;
    unsigned voffA[2], voffB[2];
#pragma unroll
    for (int i = 0; i < 2; ++i) { int R, C; stage_rc(tid * 16 + i * 8192, R, C); const int Rb = Epi::PERM ? ((R & ~31) + perm32(R & 31)) : R;
        voffA[i] = (unsigned)(R * g.lda + C) * 2u; voffB[i] = (unsigned)(Rb * K + C) * 2u; }
    const size_t kstep = (size_t)(BK * 2);
    const size_t hstepA = (size_t)HALF * g.lda * 2, hstepB = (size_t)HALF * K * 2;
    const size_t tstepA = 2 * hstepA, tstepB = 2 * hstepB;
    const unsigned ldsw = (unsigned)wid * 1024u;
    const int aoff = lds_byte(wr * 64 + fr, fq * 8), boff = lds_byte(wc * 32 + fr, fq * 8);
#define PG8_SA(b, h) (((b) * 2 + (h)) * HTB)
#define PG8_SB(b, h) ((4 + (b) * 2 + (h)) * HTB)
#define PG8_STAGE(bufoff, gbase, voff) do { _Pragma("unroll") for (int _i = 0; _i < 2; ++_i) \
        __builtin_amdgcn_global_load_lds((const unsigned*)((const char*)(gbase) + (voff)[_i]), (PG8_LAS unsigned*)(lds + (bufoff) + ldsw + _i * 8192), 16, 0, 0); } while (0)
#define PG8_LDA(dst, b, h) do { _Pragma("unroll") for (int m = 0; m < 4; ++m) _Pragma("unroll") for (int k = 0; k < 2; ++k) dst[m][k] = *(const PG8_LAS bf16x8*)(lds + PG8_SA(b, h) + aoff + m * 2048 + k * 1024); } while (0)
#define PG8_LDB(dst, b, h) do { _Pragma("unroll") for (int n = 0; n < 2; ++n) _Pragma("unroll") for (int k = 0; k < 2; ++k) dst[n][k] = *(const PG8_LAS bf16x8*)(lds + PG8_SB(b, h) + boff + n * 2048 + k * 1024); } while (0)
#define PG8_MMA(ai, bj, At, Bt) do { __builtin_amdgcn_s_setprio(1); _Pragma("unroll") for (int m = 0; m < 4; ++m) _Pragma("unroll") for (int n = 0; n < 2; ++n) _Pragma("unroll") for (int k = 0; k < 2; ++k) \
        acc[ai][bj][m][n] = __builtin_amdgcn_mfma_f32_16x16x32_bf16(Bt[n][k], At[m][k], acc[ai][bj][m][n], 0, 0, 0); __builtin_amdgcn_s_setprio(0); } while (0)
#define PG8_WAIT_V(n) asm volatile("s_waitcnt vmcnt(" #n ")" ::: "memory")
#define PG8_WAIT_L(n) asm volatile("s_waitcnt lgkmcnt(" #n ")" ::: "memory")
#define PG8_BAR __builtin_amdgcn_s_barrier()
#define PG8_SCHED __builtin_amdgcn_sched_barrier(0)
    Unit cur, nxt; int ui = 0;
    if (!S.next(0, cur)) return;
    f32x4 acc[2][2][4][2];
#pragma unroll
    for (int a = 0; a < 2; ++a)
#pragma unroll
        for (int b = 0; b < 2; ++b)
#pragma unroll
            for (int m = 0; m < 4; ++m)
#pragma unroll
                for (int n = 0; n < 2; ++n) acc[a][b][m][n] = (f32x4){0.f, 0.f, 0.f, 0.f};
    bf16x8 At[4][2], B0[2][2], B1[2][2];
    const char* cA = (const char*)g.A + (size_t)cur.pm * tstepA; const char* cB = (const char*)g.Bt + (size_t)cur.pn * tstepB;
    S.a_ready(cur);
    if constexpr (SP2) {
        PG8_STAGE(PG8_SB(0, 0), cB, voffB); PG8_STAGE(PG8_SB(0, 1), cB + hstepB, voffB); PG8_STAGE(PG8_SA(0, 0), cA, voffA); PG8_STAGE(PG8_SA(0, 1), cA + hstepA, voffA);
        if (wr == 1) PG8_BAR;
        PG8_WAIT_V(2); PG8_BAR;
        PG8_STAGE(PG8_SB(1, 0), cB + kstep, voffB); PG8_STAGE(PG8_SA(1, 0), cA + kstep, voffA); PG8_STAGE(PG8_SB(1, 1), cB + hstepB + kstep, voffB);
        PG8_WAIT_V(6); PG8_BAR;
    } else {
        PG8_STAGE(PG8_SB(0, 0), cB, voffB); PG8_STAGE(PG8_SA(0, 0), cA, voffA); PG8_STAGE(PG8_SB(0, 1), cB + hstepB, voffB); PG8_STAGE(PG8_SA(0, 1), cA + hstepA, voffA);
        if (wr == 1) PG8_BAR;
        PG8_WAIT_V(4); PG8_BAR;
        PG8_STAGE(PG8_SB(1, 0), cB + kstep, voffB); PG8_STAGE(PG8_SA(1, 0), cA + kstep, voffA); PG8_STAGE(PG8_SB(1, 1), cB + hstepB + kstep, voffB);
        PG8_WAIT_V(6); PG8_BAR;
    }
    for (;;) {
        const bool has_next = S.next(ui + 1, nxt);
        const char* nA = has_next ? (const char*)g.A + (size_t)nxt.pm * tstepA : cA; const char* nB = has_next ? (const char*)g.Bt + (size_t)nxt.pn * tstepB : cB;
        for (int t = 0; t < nt; t += 2) {
            const bool last = (t == nt - 2);
            const char* a1 = cA + (size_t)(t + 1) * kstep;
            const char* a2 = last ? nA : cA + (size_t)(t + 2) * kstep; const char* b2 = last ? nB : cB + (size_t)(t + 2) * kstep;
            const char* a3 = a2 + kstep; const char* b3 = b2 + kstep;
            if (last && has_next) S.a_ready(nxt);
            if constexpr (SP2) {
            PG8_LDB(B0, 0, 0); PG8_LDB(B1, 0, 1); PG8_SCHED; PG8_LDA(At, 0, 0); PG8_STAGE(PG8_SA(1, 1), a1 + hstepA, voffA);
            PG8_WAIT_V(8); PG8_WAIT_L(0); PG8_BAR; PG8_MMA(0, 0, At, B0); PG8_MMA(0, 1, At, B1); PG8_BAR; PG8_SCHED;
            PG8_LDA(At, 0, 1); PG8_STAGE(PG8_SB(0, 0), b2, voffB); PG8_STAGE(PG8_SB(0, 1), b2 + hstepB, voffB); PG8_STAGE(PG8_SA(0, 0), a2, voffA);
            PG8_WAIT_V(8); PG8_WAIT_L(0); PG8_BAR; PG8_MMA(1, 0, At, B0); PG8_MMA(1, 1, At, B1); PG8_BAR; PG8_SCHED;
            PG8_LDB(B0, 1, 0); PG8_LDB(B1, 1, 1); PG8_SCHED; PG8_LDA(At, 1, 0); PG8_STAGE(PG8_SA(0, 1), a2 + hstepA, voffA);
            PG8_WAIT_V(8); PG8_WAIT_L(0); PG8_BAR; PG8_MMA(0, 0, At, B0); PG8_MMA(0, 1, At, B1); PG8_BAR; PG8_SCHED;
            PG8_LDA(At, 1, 1); PG8_STAGE(PG8_SB(1, 0), b3, voffB); PG8_STAGE(PG8_SB(1, 1), b3 + hstepB, voffB); PG8_STAGE(PG8_SA(1, 0), a3, voffA);
            PG8_WAIT_V(8); PG8_WAIT_L(0); PG8_BAR; PG8_MMA(1, 0, At, B0); PG8_MMA(1, 1, At, B1); PG8_BAR; PG8_SCHED;
            } else {
            PG8_LDB(B0, 0, 0); PG8_SCHED; PG8_LDA(At, 0, 0); PG8_STAGE(PG8_SA(1, 1), a1 + hstepA, voffA);
            PG8_WAIT_L(8); PG8_BAR; PG8_WAIT_L(0); PG8_MMA(0, 0, At, B0); PG8_BAR; PG8_SCHED;
            PG8_LDB(B1, 0, 1); PG8_STAGE(PG8_SB(0, 0), b2, voffB);
            PG8_BAR; PG8_WAIT_L(0); PG8_MMA(0, 1, At, B1); PG8_BAR;
            PG8_LDA(At, 0, 1); PG8_STAGE(PG8_SA(0, 0), a2, voffA);
            PG8_BAR; PG8_WAIT_L(0); PG8_MMA(1, 0, At, B0); PG8_BAR; PG8_SCHED;
            PG8_STAGE(PG8_SB(0, 1), b2 + hstepB, voffB);
            PG8_WAIT_V(6); PG8_BAR; PG8_MMA(1, 1, At, B1); PG8_BAR;
            PG8_LDB(B0, 1, 0); PG8_SCHED; PG8_LDA(At, 1, 0); PG8_STAGE(PG8_SA(0, 1), a2 + hstepA, voffA);
            PG8_WAIT_L(8); PG8_BAR; PG8_WAIT_L(0); PG8_MMA(0, 0, At, B0); PG8_BAR; PG8_SCHED;
            PG8_LDB(B1, 1, 1); PG8_STAGE(PG8_SB(1, 0), b3, voffB);
            PG8_BAR; PG8_WAIT_L(0); PG8_MMA(0, 1, At, B1); PG8_BAR;
            PG8_LDA(At, 1, 1); PG8_STAGE(PG8_SA(1, 0), a3, voffA);
            PG8_BAR; PG8_WAIT_L(0); PG8_MMA(1, 0, At, B0); PG8_BAR; PG8_SCHED;
            PG8_STAGE(PG8_SB(1, 1), b3 + hstepB, voffB);
            PG8_WAIT_V(6); PG8_BAR; PG8_MMA(1, 1, At, B1); PG8_BAR;
            }
        }
        if constexpr (ALIGN_EPI) { if (wr == 0) PG8_BAR; }
        if constexpr (!Epi::AFTER_DRAIN) { E(acc, cur, wr, wc, fr, fq); S.done(cur); }
        if (!has_next) break;
#pragma unroll
        for (int a = 0; a < 2; ++a)
#pragma unroll
            for (int b = 0; b < 2; ++b)
#pragma unroll
                for (int m = 0; m < 4; ++m)
#pragma unroll
                    for (int n = 0; n < 2; ++n) acc[a][b][m][n] = (f32x4){0.f, 0.f, 0.f, 0.f};
        cur = nxt; cA = nA; cB = nB; ++ui;
        if constexpr (ALIGN_EPI) { if (wr == 1) PG8_BAR; }
    }
    PG8_WAIT_V(0);
    if constexpr (!ALIGN_EPI) { if (wr == 0) PG8_BAR; }
    PG8_BAR;
    if constexpr (Epi::AFTER_DRAIN) { E.fused(acc, cur, wr, wc, fr, fq, lds, wid, lane); S.done(cur); }
#undef PG8_SA
#undef PG8_SB
#undef PG8_STAGE
#undef PG8_LDA
#undef PG8_LDB
#undef PG8_MMA
#undef PG8_WAIT_V
#undef PG8_WAIT_L
#undef PG8_BAR
#undef PG8_SCHED
}
}

#ifndef PG8_SP2
#define PG8_SP2 true
#endif
#ifndef PG8_ALIGN
#define PG8_ALIGN true
#endif

constexpr int NWAVES = 8;
constexpr int D = 1024, BATCH = 8, SEQ = 2048, M = BATCH * SEQ, DG = 2048, NH = 2 * DG, NGRP = 8, GDIM = 256, GBLK = 128, FF = 4096;
constexpr float LN_EPS = 1e-5f, ALPHA = 1.4142135623730951f;
constexpr size_t MiB = 1u << 20;
constexpr size_t WS_CTL = 0, CTL_ZERO_BYTES = 1 * MiB;
constexpr size_t WS_WSM = 1 * MiB;
constexpr size_t WS_VST = 2 * MiB;
constexpr size_t WS_WAIN = 8 * MiB, WS_WAOUT = 16 * MiB, WS_WBIN = 20 * MiB, WS_WBOUT = 26 * MiB, WS_W1 = 28 * MiB, WS_W2 = 44 * MiB;
constexpr size_t WS_XN = 64 * MiB;
constexpr size_t WS_H = 96 * MiB;
constexpr size_t WS_END = 224 * MiB;
constexpr int LDS_BYTES = 147456, MISC_OFF = 131072 + 1024;
constexpr int CW_BAR = 4096, CW_SEAM = 16384, SEAM_BANK = 64 * 64, CTL_WORDS = CW_SEAM + 4 * SEAM_BANK;

#define GAS __attribute__((address_space(1)))
#define LAS __attribute__((address_space(3)))
typedef unsigned short bf16;
typedef unsigned v4u __attribute__((ext_vector_type(4)));
typedef unsigned v2u __attribute__((ext_vector_type(2)));
typedef float f32x4 __attribute__((ext_vector_type(4)));
typedef short bf16x8 __attribute__((ext_vector_type(8)));
#define LDS_WAIT() asm volatile("s_waitcnt lgkmcnt(0)" ::: "memory")
__device__ __forceinline__ unsigned pk2(float lo, float hi) { return pg8::cvt_pk_bf16(lo, hi); }
__device__ __forceinline__ float bflo(unsigned w) { return __uint_as_float(w << 16); }
__device__ __forceinline__ float bfhi(unsigned w) { return __uint_as_float(w & 0xffff0000u); }
__device__ __forceinline__ float wave_sum(float v) {
#pragma unroll
    for (int o = 1; o < 64; o <<= 1) v += __shfl_xor(v, o);
    return v;
}

__device__ __forceinline__ void p0_transpose_item(const float* W, int K, int N, bf16* WT, LAS float* scr, int item, int lane) {
    const int nblk = N / 32, kb = item / nblk, nb = item % nblk, k0 = 64 * kb, n0 = 32 * nb;
#pragma unroll 8
    for (int i = 0; i < 32; ++i) { const int kk = 2 * i + (lane >> 5); scr[kk * 33 + (lane & 31)] = W[(size_t)(k0 + kk) * N + n0 + (lane & 31)]; }
    LDS_WAIT(); asm volatile("" ::: "memory");
    const int c = lane & 7;
#pragma unroll
    for (int j = 0; j < 4; ++j) { const int n = (lane >> 3) + 8 * j; const LAS float* s = scr + (8 * c) * 33 + n;
        v4u o; o.x = pk2(s[0 * 33], s[1 * 33]); o.y = pk2(s[2 * 33], s[3 * 33]); o.z = pk2(s[4 * 33], s[5 * 33]); o.w = pk2(s[6 * 33], s[7 * 33]);
        *(v4u*)(WT + (size_t)(n0 + n) * K + k0 + 8 * c) = o; }
    LDS_WAIT(); asm volatile("" ::: "memory");
}

#define XB_TMO      128
#define XB_XCNT(j)  (256  + 64 * (j))
#define XB_XSUB(j)  (1280 + 64 * (j))
#define XB_XGEN(j)  (2304 + 64 * (j))
#define XB_TOP      3328
#define XB_TOPGEN   3392
#define XCD_BAR_WORDS 3456
#define XB_SPIN_CAP (1u << 18)

__device__ __forceinline__ unsigned xb_ld(unsigned* p)              { return __hip_atomic_load(p, __ATOMIC_RELAXED, __HIP_MEMORY_SCOPE_AGENT); }
__device__ __forceinline__ unsigned xb_add(unsigned* p, unsigned v) { return __hip_atomic_fetch_add(p, v, __ATOMIC_RELAXED, __HIP_MEMORY_SCOPE_AGENT); }
__device__ __forceinline__ unsigned xb_xcc_id() { return (unsigned)__builtin_amdgcn_s_getreg((3 << 11) | 20) & 0xFu; }
#define XB_SPIN(cond, bar) do { unsigned _sp = 0; while (cond) { __builtin_amdgcn_s_sleep(1); \
    if ((++_sp & 255u) == 0u) { if (xb_ld(&(bar)[XB_TMO])) break; if (_sp > XB_SPIN_CAP) { atomicAdd(&(bar)[XB_TMO], 1u); break; } } } } while (0)

struct XcdBarrier {
    unsigned* bar; unsigned x;
    volatile LAS unsigned* st;
};

__device__ __forceinline__ XcdBarrier xcd_barrier_post(unsigned* bar, volatile LAS unsigned* st) {
    XcdBarrier b; b.bar = bar; b.x = xb_xcc_id(); b.st = st;
    if (threadIdx.x == 0) (void)xb_add(&bar[XB_XCNT(b.x)], 1u);
    return b;
}
__device__ __forceinline__ void xcd_barrier_complete(unsigned* bar, unsigned x, unsigned& nloc, unsigned& nx) {
    const unsigned G = gridDim.x * gridDim.y * gridDim.z;
    unsigned sum, cnt, mine, sp = 0u;
    for (;;) {
        sum = 0u; cnt = 0u; mine = 0u;
#pragma unroll
        for (unsigned j = 0; j < 16; ++j) { const unsigned c = xb_ld(&bar[XB_XCNT(j)]); sum += c; cnt += (c > 0u) ? 1u : 0u; mine = (j == x) ? c : mine; }
        if (sum == G) break;
        __builtin_amdgcn_s_sleep(1);
        if ((++sp & 255u) == 0u) { if (xb_ld(&bar[XB_TMO])) break; if (sp > XB_SPIN_CAP) { atomicAdd(&bar[XB_TMO], 1u); break; } }
    }
    nloc = mine > 0u ? mine : 1u; nx = cnt > 0u ? cnt : 1u;
}

__device__ __forceinline__ void xcd_barrier(const XcdBarrier& b) {
    asm volatile("s_waitcnt vmcnt(0)" ::: "memory");
    __syncthreads();
    if (threadIdx.x == 0) {
        unsigned* bar = b.bar;
        __builtin_amdgcn_s_waitcnt(0);
        unsigned nloc = b.st[0], nx = b.st[1];
        if (nloc == 0u) { xcd_barrier_complete(bar, b.x, nloc, nx); b.st[0] = nloc; b.st[1] = nx; }
        const unsigned old = xb_add(&bar[XB_XSUB(b.x)], 1u);
        const unsigned gen = old / nloc;
        if (old + 1u == (gen + 1u) * nloc) {
            __builtin_amdgcn_fence(__ATOMIC_RELEASE, "agent");
            asm volatile("s_waitcnt vmcnt(0)" ::: "memory");
            const unsigned og = xb_add(&bar[XB_TOP], 1u);
            const unsigned tg = og / nx;
            if (og + 1u == (tg + 1u) * nx) xb_add(&bar[XB_TOPGEN], 1u);
            else XB_SPIN(xb_ld(&bar[XB_TOPGEN]) == tg, bar);
            __builtin_amdgcn_fence(__ATOMIC_ACQUIRE, "agent");
            xb_add(&bar[XB_XGEN(b.x)], 1u);
            asm volatile("s_waitcnt vmcnt(0)" ::: "memory");
        } else {
            XB_SPIN(xb_ld(&bar[XB_XGEN(b.x)]) == gen, bar);
            __builtin_amdgcn_fence(__ATOMIC_ACQUIRE, "agent");
            asm volatile("s_waitcnt vmcnt(0)" ::: "memory");
        }
    }
    __syncthreads();
}
struct Args { const float* in[16]; float* out; unsigned char* ws; };

__device__ __forceinline__ void ln_rows(float* X, bf16* XN, const float* g, const float* b, int gw, int NGW, int lane) {
    f32x4 gv[4], bv[4];
#pragma unroll
    for (int j = 0; j < 4; ++j) { gv[j] = ((const f32x4*)g)[lane + 64 * j]; bv[j] = ((const f32x4*)b)[lane + 64 * j]; }
    for (int m = gw; m < M; m += NGW) {
        f32x4* xr = (f32x4*)(X + (size_t)m * D) + lane;
        f32x4 v[4]; float s = 0.f;
#pragma unroll
        for (int j = 0; j < 4; ++j) { v[j] = xr[64 * j]; s += (v[j].x + v[j].y) + (v[j].z + v[j].w); }
        const float mean = wave_sum(s) * (1.f / D); float s2 = 0.f;
#pragma unroll
        for (int j = 0; j < 4; ++j) { v[j] = v[j] - mean; s2 += (v[j].x * v[j].x + v[j].y * v[j].y) + (v[j].z * v[j].z + v[j].w * v[j].w); }
        const float rstd = 1.f / sqrtf(wave_sum(s2) * (1.f / D) + LN_EPS);
        v2u* o8 = (v2u*)(XN + (size_t)m * D) + lane;
#pragma unroll
        for (int j = 0; j < 4; ++j) { const f32x4 y = v[j] * rstd * gv[j] + bv[j]; xr[64 * j] = y; v2u w; w.x = pk2(y.x, y.y); w.y = pk2(y.z, y.w); o8[64 * j] = w; }
    }
}

__global__ void __launch_bounds__(NWAVES * 64, 2) fwd_kernel(Args args) {
    extern __shared__ __attribute__((aligned(16))) unsigned char lds_raw[];
    cg::grid_group grid = cg::this_grid();
    LAS unsigned char* lds = (LAS unsigned char*)lds_raw;
#define PHASE_IDS() int tid_l = threadIdx.x; asm volatile("" : "+v"(tid_l)); const int tid = tid_l, lane = tid & 63, wave = __builtin_amdgcn_readfirstlane(tid >> 6), gw = bid * NWAVES + wave; (void)lane; (void)gw
    const int G = gridDim.x, bid = blockIdx.x, NGW = G * NWAVES;

    unsigned char* ws = args.ws;
    XcdBarrier xbar; xbar.bar = (unsigned*)(ws + WS_CTL) + CW_BAR; xbar.x = 0; xbar.st = (volatile LAS unsigned*)(lds + MISC_OFF + 32);
#ifdef PROBE_SYNC2
#define GSYNC() do { xcd_barrier(xbar); xcd_barrier(xbar); } while (0)
#else
#define GSYNC() xcd_barrier(xbar)
#endif
#define PROBE_FINAL() do {} while (0)
    const float* x = args.in[0]; const float* ln_g = args.in[1]; const float* ln_b = args.in[2];
    const float* a_w_in = args.in[3]; const float* a_b_in = args.in[4]; const float* a_v_g = args.in[5]; const float* a_v_b = args.in[6];
    const float* a_w_s = args.in[7]; const float* a_b_s = args.in[8]; const float* a_w_out = args.in[9]; const float* a_b_out = args.in[10];
    const float* b_w_in = args.in[11]; const float* b_conv = args.in[12]; const float* b_w_out = args.in[13];
    const float* mlp_w1 = args.in[14]; const float* mlp_w2 = args.in[15];
    float* out = args.out;
    bf16* WSM = (bf16*)(ws + WS_WSM); float* VST = (float*)(ws + WS_VST);
    bf16* WAIN = (bf16*)(ws + WS_WAIN); bf16* WAOUT = (bf16*)(ws + WS_WAOUT); bf16* WBIN = (bf16*)(ws + WS_WBIN); bf16* WBOUT = (bf16*)(ws + WS_WBOUT);
    bf16* W1T = (bf16*)(ws + WS_W1); bf16* W2T = (bf16*)(ws + WS_W2);
    bf16* XN = (bf16*)(ws + WS_XN); bf16* H = (bf16*)(ws + WS_H);

    {
        PHASE_IDS();
        for (int i = bid * 512 + tid; i < CTL_WORDS; i += G * 512) ((unsigned*)(ws + WS_CTL))[i] = 0u;
        if (tid < 64) ((LAS unsigned*)(lds + MISC_OFF))[tid] = 0u;
        LAS float* scr = (LAS float*)(lds + wave * 16384);
        constexpr int I_AIN = (D / 64) * (NH / 32), I_AOUT = (DG / 64) * (D / 32), I_BIN = (D / 64) * (3 * D / 32), I_BOUT = (D / 64) * (D / 32), I_W1 = (D / 64) * (FF / 32), I_W2 = (FF / 64) * (D / 32);
        constexpr int NITEMS = I_AIN + I_AOUT + I_BIN + I_BOUT + 2 * I_W1 + 2 * I_W2;
        for (int it = gw; it < NITEMS; it += NGW) {
            int r = it;
            if (r < I_AIN) { p0_transpose_item(a_w_in, D, NH, WAIN, scr, r, lane); continue; } r -= I_AIN;
            if (r < I_AOUT) { p0_transpose_item(a_w_out, DG, D, WAOUT, scr, r, lane); continue; } r -= I_AOUT;
            if (r < I_BIN) { p0_transpose_item(b_w_in, D, 3 * D, WBIN, scr, r, lane); continue; } r -= I_BIN;
            if (r < I_BOUT) { p0_transpose_item(b_w_out, D, D, WBOUT, scr, r, lane); continue; } r -= I_BOUT;
            if (r < 2 * I_W1) { const int l = r / I_W1; p0_transpose_item(mlp_w1 + (size_t)l * D * FF, D, FF, W1T + (size_t)l * D * FF, scr, r % I_W1, lane); continue; } r -= 2 * I_W1;
            { const int l = r / I_W2; p0_transpose_item(mlp_w2 + (size_t)l * D * FF, FF, D, W2T + (size_t)l * D * FF, scr, r % I_W2, lane); }
        }
        for (int m = gw; m < M; m += NGW) {
            const f32x4* xr = (const f32x4*)(x + (size_t)m * D) + lane; v2u* o8 = (v2u*)(XN + (size_t)m * D) + lane;
#pragma unroll
            for (int j = 0; j < 4; ++j) { const f32x4 v = xr[64 * j]; v2u w; w.x = pk2(v.x, v.y); w.y = pk2(v.z, v.w); o8[64 * j] = w; }
        }
        for (int i = (bid * 512 + tid) * 4; i < NGRP * GBLK * GBLK; i += G * 512 * 4) {
            const int t = (i >> 7) & 127, s = i & 127; f32x4 v = *(const f32x4*)(a_w_s + i);
            if (t < 64 && s >= 64) v = (f32x4){0.f, 0.f, 0.f, 0.f};
            v2u w; w.x = pk2(v.x, v.y); w.y = pk2(v.z, v.w); *(v2u*)(WSM + i) = w;
        }
    }
    grid.sync();
    xbar = xcd_barrier_post((unsigned*)(ws + WS_CTL) + CW_BAR, (volatile LAS unsigned*)(lds + MISC_OFF + 32));

#pragma unroll 1
    for (int layer = 0; layer < 2; ++layer) {
        pg8::Gemm gmix; const float* mixbias; const float* xin;
        if (layer == 0) {
            { pg8::Gemm g{XN, WAIN, M, NH, D, D}; pg8::StaticOrder S; S.init(M, NH, G, bid); pg8::EpiBf16<1> E{H, NH, a_b_in};
              pg8::gemm_phase<pg8::EpiBf16<1>, pg8::StaticOrder, PG8_ALIGN, PG8_SP2>(lds, g, S, E); }
            GSYNC();
            { PHASE_IDS();
            for (int m = gw; m < M; m += NGW) {
                const v4u* vr = (const v4u*)(H + (size_t)m * NH + DG) + lane; v4u r[4]; float s = 0.f;
#pragma unroll
                for (int j = 0; j < 4; ++j) { r[j] = vr[64 * j]; s += (bflo(r[j].x) + bfhi(r[j].x)) + (bflo(r[j].y) + bfhi(r[j].y)) + (bflo(r[j].z) + bfhi(r[j].z)) + (bflo(r[j].w) + bfhi(r[j].w)); }
                const float mean = wave_sum(s) * (1.f / DG); float q = 0.f;
#pragma unroll
                for (int j = 0; j < 4; ++j) {
#pragma unroll
                    for (int e = 0; e < 4; ++e) { const float a = bflo(r[j][e]) - mean, b = bfhi(r[j][e]) - mean; q += a * a + b * b; } }
                const float rstd = 1.f / sqrtf(wave_sum(q) * (1.f / DG) + LN_EPS);
                if (lane == 0) { VST[2 * m] = mean; VST[2 * m + 1] = rstd; }
            } }
            GSYNC();
            {
                PHASE_IDS();
                LAS bf16* WA = (LAS bf16*)lds;
                LAS bf16* VT = (LAS bf16*)(lds + 34816);
                const int wr = wave >> 2, wc = wave & 3, fr = lane & 15, fq = lane >> 4;
                for (int item = bid; item < (M / GBLK) * NGRP; item += G) {
                    const int nb = item >> 3, g = item & 7, row0 = nb * GBLK;
                    __syncthreads();
#pragma unroll
                    for (int i = 0; i < 4; ++i) { const int ch = tid + i * 512, t = ch >> 4, sc = ch & 15;
                        const v4u w = *(const v4u*)(WSM + (size_t)(g * GBLK + t) * GBLK + sc * 8); *(LAS v4u*)(WA + t * 136 + sc * 8) = w; }
                    v4u raw[2][4]; float mu[2], rs[2];
#pragma unroll
                    for (int h = 0; h < 2; ++h) { const int s = lane + 64 * h; mu[h] = VST[2 * (row0 + s)]; rs[h] = VST[2 * (row0 + s) + 1];
#pragma unroll
                        for (int j = 0; j < 4; ++j) raw[h][j] = *(const v4u*)(H + (size_t)(row0 + s) * NH + DG + g * GDIM + (wave * 4 + j) * 8); }
#pragma unroll
                    for (int j = 0; j < 4; ++j) { const int c0 = (wave * 4 + j) * 8;
                        const f32x4 g0 = *(const f32x4*)(a_v_g + g * GDIM + c0), g1 = *(const f32x4*)(a_v_g + g * GDIM + c0 + 4);
                        const f32x4 b0 = *(const f32x4*)(a_v_b + g * GDIM + c0), b1 = *(const f32x4*)(a_v_b + g * GDIM + c0 + 4);
#pragma unroll
                        for (int h = 0; h < 2; ++h) { const int s = lane + 64 * h; const v4u r = raw[h][j]; LAS bf16* dst = VT + c0 * 136 + s;
                            float y[8];
                            y[0] = (bflo(r.x) - mu[h]) * rs[h] * g0.x + b0.x; y[1] = (bfhi(r.x) - mu[h]) * rs[h] * g0.y + b0.y;
                            y[2] = (bflo(r.y) - mu[h]) * rs[h] * g0.z + b0.z; y[3] = (bfhi(r.y) - mu[h]) * rs[h] * g0.w + b0.w;
                            y[4] = (bflo(r.z) - mu[h]) * rs[h] * g1.x + b1.x; y[5] = (bfhi(r.z) - mu[h]) * rs[h] * g1.y + b1.y;
                            y[6] = (bflo(r.w) - mu[h]) * rs[h] * g1.z + b1.z; y[7] = (bfhi(r.w) - mu[h]) * rs[h] * g1.w + b1.w;
#pragma unroll
                            for (int e = 0; e < 8; e += 2) { const unsigned p = pk2(y[e], y[e + 1]); dst[e * 136] = (bf16)(p & 0xffffu); dst[(e + 1) * 136] = (bf16)(p >> 16); } } }
                    __syncthreads();
                    f32x4 acc[4][4];
#pragma unroll
                    for (int m = 0; m < 4; ++m)
#pragma unroll
                        for (int n = 0; n < 4; ++n) acc[m][n] = (f32x4){0.f, 0.f, 0.f, 0.f};
#pragma unroll
                    for (int kk = 0; kk < 4; ++kk) {
                        bf16x8 af[4], bfr[4];
#pragma unroll
                        for (int m = 0; m < 4; ++m) af[m] = *(const LAS bf16x8*)(WA + (wr * 64 + m * 16 + fr) * 136 + kk * 32 + fq * 8);
#pragma unroll
                        for (int n = 0; n < 4; ++n) bfr[n] = *(const LAS bf16x8*)(VT + (wc * 64 + (n >> 1) * 32 + 8 * (fr >> 2) + 4 * (n & 1) + (fr & 3)) * 136 + kk * 32 + fq * 8);
#pragma unroll
                        for (int m = 0; m < 4; ++m)
#pragma unroll
                            for (int n = 0; n < 4; ++n) acc[m][n] = __builtin_amdgcn_mfma_f32_16x16x32_bf16(bfr[n], af[m], acc[m][n], 0, 0, 0);
                    }
#pragma unroll
                    for (int m = 0; m < 4; ++m) { const int t = wr * 64 + m * 16 + fr; const float bs = a_b_s[g * GBLK + t];
#pragma unroll
                        for (int p = 0; p < 2; ++p) { bf16* up = H + (size_t)(row0 + t) * NH + g * GDIM + wc * 64 + p * 32 + 8 * fq;
                            const v4u uu = *(const v4u*)up; const f32x4 a0 = acc[m][2 * p] + bs, a1 = acc[m][2 * p + 1] + bs; v4u o;
                            o.x = pk2(bflo(uu.x) * a0.x, bfhi(uu.x) * a0.y); o.y = pk2(bflo(uu.y) * a0.z, bfhi(uu.y) * a0.w);
                            o.z = pk2(bflo(uu.z) * a1.x, bfhi(uu.z) * a1.y); o.w = pk2(bflo(uu.w) * a1.z, bfhi(uu.w) * a1.w);
                            *(v4u*)up = o; } }
                }
                __syncthreads();
            }
            gmix = pg8::Gemm{H, WAOUT, M, D, DG, NH}; mixbias = a_b_out; xin = x;
        } else {
            { pg8::Gemm g{XN, WBIN, M, 3 * D, D, D}; pg8::StaticOrder S; S.init(M, 3 * D, G, bid); pg8::EpiBf16<0> E{H, 3 * D, nullptr};
              pg8::gemm_phase<pg8::EpiBf16<0>, pg8::StaticOrder, PG8_ALIGN, PG8_SP2>(lds, g, S, E); }
            GSYNC();
            {
                PHASE_IDS();
                const int cgp = tid & 127, rsub = tid >> 7, ch = cgp * 8;
                float w0[8], w1[8], w2[8];
#pragma unroll
                for (int e = 0; e < 8; ++e) { w0[e] = b_conv[ch + e]; w1[e] = b_conv[D + ch + e]; w2[e] = b_conv[2 * D + ch + e]; }
                for (int it = bid; it < M / 64; it += G) {
                    const int t0 = it * 64 + rsub * 16; float p1[8], p2[8];
                    if ((t0 % SEQ) == 0) {
#pragma unroll
                        for (int e = 0; e < 8; ++e) { p1[e] = 0.f; p2[e] = 0.f; }
                    } else {
                        const v4u c2 = *(const v4u*)(H + (size_t)(t0 - 2) * (3 * D) + D + ch), h2 = *(const v4u*)(H + (size_t)(t0 - 2) * (3 * D) + 2 * D + ch);
                        const v4u c1 = *(const v4u*)(H + (size_t)(t0 - 1) * (3 * D) + D + ch), h1 = *(const v4u*)(H + (size_t)(t0 - 1) * (3 * D) + 2 * D + ch);
#pragma unroll
                        for (int e = 0; e < 4; ++e) { p2[2 * e] = bflo(c2[e]) * bflo(h2[e]); p2[2 * e + 1] = bfhi(c2[e]) * bfhi(h2[e]); p1[2 * e] = bflo(c1[e]) * bflo(h1[e]); p1[2 * e + 1] = bfhi(c1[e]) * bfhi(h1[e]); }
                    }
#pragma unroll 4
                    for (int r = 0; r < 16; ++r) {
                        bf16* bp = H + (size_t)(t0 + r) * (3 * D) + ch;
                        const v4u bb = *(const v4u*)bp, cc = *(const v4u*)(bp + D), hh = *(const v4u*)(bp + 2 * D); v4u o;
#pragma unroll
                        for (int e = 0; e < 4; ++e) {
                            const float q0 = bflo(cc[e]) * bflo(hh[e]), q1 = bfhi(cc[e]) * bfhi(hh[e]);
                            const float o0 = bflo(bb[e]) * (w0[2 * e] * p2[2 * e] + w1[2 * e] * p1[2 * e] + w2[2 * e] * q0);
                            const float o1 = bfhi(bb[e]) * (w0[2 * e + 1] * p2[2 * e + 1] + w1[2 * e + 1] * p1[2 * e + 1] + w2[2 * e + 1] * q1);
                            o[e] = pk2(o0, o1); p2[2 * e] = p1[2 * e]; p2[2 * e + 1] = p1[2 * e + 1]; p1[2 * e] = q0; p1[2 * e + 1] = q1;
                        }
                        *(v4u*)bp = o;
                    }
                }
            }
            gmix = pg8::Gemm{H, WBOUT, M, D, D, 3 * D}; mixbias = nullptr; xin = out;
        }
        GSYNC();
        { pg8::StaticOrder S; S.init(M, D, G, bid); pg8::EpiResF32 E{xin, out, D, mixbias, ALPHA};
          pg8::gemm_phase<pg8::EpiResF32, pg8::StaticOrder, PG8_ALIGN, PG8_SP2>(lds, gmix, S, E); }
        GSYNC();
        { PHASE_IDS(); ln_rows(out, XN, ln_g + (size_t)(layer * 2 + 0) * D, ln_b + (size_t)(layer * 2 + 0) * D, gw, NGW, lane); }
        GSYNC();
        { pg8::Gemm g{XN, W1T + (size_t)layer * D * FF, M, FF, D, D}; pg8::StaticOrder S; S.init(M, FF, G, bid); pg8::EpiBf16<2> E{H, FF, nullptr};
          pg8::gemm_phase<pg8::EpiBf16<2>, pg8::StaticOrder, PG8_ALIGN, PG8_SP2>(lds, g, S, E); }
        GSYNC();
        { pg8::Gemm g{H, W2T + (size_t)layer * D * FF, M, D, FF, FF}; pg8::StaticOrder S; S.init(M, D, G, bid); pg8::EpiResF32 E{out, out, D, nullptr, ALPHA};
          pg8::gemm_phase<pg8::EpiResF32, pg8::StaticOrder, PG8_ALIGN, PG8_SP2>(lds, g, S, E); }
        GSYNC();
        { PHASE_IDS(); ln_rows(out, XN, ln_g + (size_t)(layer * 2 + 1) * D, ln_b + (size_t)(layer * 2 + 1) * D, gw, NGW, lane); }
        if (layer == 0) GSYNC();
        else { PROBE_FINAL(); }
    }
}

extern "C" void kernel_launch(void* const* d_in, const int* in_sizes, int n_in, void* d_out, int out_size, void* d_ws, size_t ws_size, hipStream_t stream) {
    static int grid = 0;
    if (grid == 0) {
        if (n_in != 16 || in_sizes[0] != M * D || out_size != M * D || ws_size < WS_END) { fprintf(stderr, "kernel_launch: unexpected shapes (n_in %d, in0 %d, out %d, ws %zu)\n", n_in, n_in > 0 ? in_sizes[0] : -1, out_size, ws_size); grid = -1; return; }
        int dev = 0, cus = 0, per_cu = 0;
        if (hipGetDevice(&dev) != hipSuccess || hipDeviceGetAttribute(&cus, hipDeviceAttributeMultiprocessorCount, dev) != hipSuccess) { grid = -1; return; }
        if (hipFuncSetAttribute((const void*)fwd_kernel, hipFuncAttributeMaxDynamicSharedMemorySize, LDS_BYTES) != hipSuccess) { fprintf(stderr, "kernel_launch: hipFuncSetAttribute failed\n"); grid = -1; return; }
        if (hipOccupancyMaxActiveBlocksPerMultiprocessor(&per_cu, (const void*)fwd_kernel, NWAVES * 64, LDS_BYTES) != hipSuccess || per_cu < 1) { fprintf(stderr, "kernel_launch: occupancy query reports %d\n", per_cu); (void)hipGetLastError(); grid = -1; return; }
        grid = cus;
        fprintf(stderr, "kernel_launch: cus %d per_cu %d grid %d\n", cus, per_cu, grid);
    }
    if (grid < 0) return;
    Args a{};
    for (int i = 0; i < 16; ++i) a.in[i] = (const float*)d_in[i];
    a.out = (float*)d_out; a.ws = (unsigned char*)d_ws;
    void* kargs[] = {&a};
    const hipError_t e = hipLaunchCooperativeKernel((const void*)fwd_kernel, dim3(grid), dim3(NWAVES * 64), kargs, LDS_BYTES, stream);
    if (e != hipSuccess) fprintf(stderr, "kernel_launch: cooperative launch failed: %s (grid %d)\n", hipGetErrorString(e), grid);
}
```

```cpp
#include <hip/hip_runtime.h>
#include <hip/hip_cooperative_groups.h>
#include <cstdio>
#include <cstdint>
namespace cg = cooperative_groups;
namespace pg8 {
#define PG8_LAS __attribute__((address_space(3)))
typedef unsigned short bf16_t;
typedef short bf16x8 __attribute__((ext_vector_type(8)));
typedef float f32x4 __attribute__((ext_vector_type(4)));
typedef unsigned u32x4 __attribute__((ext_vector_type(4)));
constexpr int BM = 256, BK = 64, HALF = 128, HTB = HALF * BK * 2  , STAGE_BYTES = 8 * HTB, NXCD = 8, WGM = 8;

__host__ __device__ __forceinline__ int lds_byte(int r, int c) { const int st = (r >> 4) * 2 + (c >> 5), rr = r & 15, cc = c & 31, ob = rr * 64 + cc * 2; return st * 1024 + (ob ^ (((ob >> 9) & 1) << 5)); }
__host__ __device__ __forceinline__ void stage_rc(int b, int& R, int& C) { const int st = b / 1024, sb = b % 1024, swz = sb ^ (((sb >> 9) & 1) << 5); R = (st >> 1) * 16 + swz / 64; C = (st & 1) * 32 + (swz % 64) / 2; }
__host__ __device__ __forceinline__ int perm32(int rho) { const int n = rho >> 4, i = rho & 15; return 8 * (i >> 2) + 4 * n + (i & 3); }

struct Unit { int pm, pn; };
struct Gemm { const bf16_t* A; const bf16_t* Bt; int M, N, K, lda; };

struct StaticOrder {
    int nM, nN, nwg, G, c;
    __host__ __device__ void init(int M, int N, int G_, int c_) { nM = M / BM; nN = N / BM; nwg = nM * nN; G = G_; c = c_; }
    __host__ __device__ bool next(int i, Unit& u) const {
        const long L = (long)i * G + c; if (L >= nwg) return false;
        int wgid = (int)L; { const int q = nwg / NXCD, r = nwg % NXCD, xcd = wgid % NXCD, off = wgid / NXCD; wgid = (xcd < r ? xcd * (q + 1) : r * (q + 1) + (xcd - r) * q) + off; }
        const int nig = WGM * nN, gid = wgid / nig, fm = gid * WGM, gsz = (nM - fm) < WGM ? (nM - fm) : WGM;
        u.pm = fm + ((wgid % nig) % gsz); u.pn = (wgid % nig) / gsz; return true;
    }
    __device__ __forceinline__ void a_ready(const Unit&) const {}
    __device__ __forceinline__ void done(const Unit&) const {}
};

__device__ __forceinline__ unsigned cvt_pk_bf16(float lo, float hi) { unsigned r; asm volatile("v_cvt_pk_bf16_f32 %0, %1, %2" : "=v"(r) : "v"(lo), "v"(hi)); return r; }
typedef float f32x2 __attribute__((ext_vector_type(2)));
__device__ __forceinline__ f32x2 gelu_pk(f32x2 v) {
    const f32x2 av = __builtin_elementwise_abs(v), d = av * 0.2316418882f + 1.0f;
    f32x2 t; t.x = __builtin_amdgcn_rcpf(d.x); t.y = __builtin_amdgcn_rcpf(d.y);
    f32x2 q = t * 0.5307027145f + (-0.7265760135f); q = q * t + 0.7107068705f; q = q * t + (-0.142248368f); q = q * t + 0.127414796f; q = q * t;
    const f32x2 s = (v * v) * (-0.72134752044f);
    f32x2 e; e.x = __builtin_amdgcn_exp2f(s.x); e.y = __builtin_amdgcn_exp2f(s.y);
    const f32x2 m = v * (q * e), r = v - m;
    f32x2 o; o.x = v.x < 0.f ? m.x : r.x; o.y = v.y < 0.f ? m.y : r.y; return o;
}
template <int ACT, bool STATS = false> struct EpiBf16 {
    static constexpr bool PERM = true, AFTER_DRAIN = false;
    bf16_t* O; int ldc; const float* bias; float* vpart; int stat_pn0;
    __device__ __forceinline__ void operator()(const f32x4 (&acc)[2][2][4][2], const Unit& u, int wr, int wc, int fr, int fq) const {
        const int row0 = u.pm * BM + wr * 64 + fr; const int col0 = u.pn * BM + wc * 32 + 8 * fq;
        const bool do_stats = STATS && u.pn >= stat_pn0;
        f32x4 bv[2][2];
#pragma unroll
        for (int bj = 0; bj < 2; ++bj)
#pragma unroll
            for (int n = 0; n < 2; ++n) bv[bj][n] = bias ? *(const f32x4*)(bias + col0 + bj * HALF + 4 * n) : (f32x4){0.f, 0.f, 0.f, 0.f};
#pragma unroll
        for (int ai = 0; ai < 2; ++ai)
#pragma unroll
            for (int m = 0; m < 4; ++m) { bf16_t* rowp = O + (size_t)(row0 + ai * HALF + m * 16) * ldc + col0; float ss = 0.f, qq = 0.f;
#pragma unroll
                for (int bj = 0; bj < 2; ++bj) { f32x4 v0 = acc[ai][bj][m][0] + bv[bj][0], v1 = acc[ai][bj][m][1] + bv[bj][1];
                    if (ACT == 1) { f32x2 a = gelu_pk((f32x2){v0[0], v0[1]}), b = gelu_pk((f32x2){v0[2], v0[3]}), c = gelu_pk((f32x2){v1[0], v1[1]}), d = gelu_pk((f32x2){v1[2], v1[3]});
                        v0 = (f32x4){a.x, a.y, b.x, b.y}; v1 = (f32x4){c.x, c.y, d.x, d.y}; }
                    if (ACT == 2) { v0 = __builtin_elementwise_max(v0, (f32x4){0.f, 0.f, 0.f, 0.f}); v1 = __builtin_elementwise_max(v1, (f32x4){0.f, 0.f, 0.f, 0.f}); v0 = v0 * v0; v1 = v1 * v1; }
                    if (STATS) { ss += ((v0[0] + v0[1]) + (v0[2] + v0[3])) + ((v1[0] + v1[1]) + (v1[2] + v1[3])); const f32x4 a2 = v0 * v0, b2 = v1 * v1; qq += ((a2[0] + a2[1]) + (a2[2] + a2[3])) + ((b2[0] + b2[1]) + (b2[2] + b2[3])); }
                    u32x4 w; w.x = cvt_pk_bf16(v0[0], v0[1]); w.y = cvt_pk_bf16(v0[2], v0[3]); w.z = cvt_pk_bf16(v1[0], v1[1]); w.w = cvt_pk_bf16(v1[2], v1[3]);
                    *(u32x4*)(rowp + bj * HALF) = w;
#ifdef PROBE_ST2
                    if (STATS) *(u32x4*)((bf16_t*)vpart + (size_t)(110u << 20) + (size_t)(row0 + ai * HALF + m * 16) * 1024 + ((col0 + bj * HALF) & 1023)) = w;
#endif
                    }
                if (STATS) { if (do_stats) { ss += __shfl_xor(ss, 16); ss += __shfl_xor(ss, 32); qq += __shfl_xor(qq, 16); qq += __shfl_xor(qq, 32);
                    if (fq == 0) *(f32x2*)(vpart + ((size_t)(row0 + ai * HALF + m * 16) * 32 + (u.pn - stat_pn0) * 4 + wc) * 2) = (f32x2){ss, qq}; } } }
    }
};
struct EpiResF32 {
    static constexpr bool PERM = false, AFTER_DRAIN = false;
    const float* base; float* out; int ldc; const float* bias; float alpha;
    __device__ __forceinline__ void operator()(const f32x4 (&acc)[2][2][4][2], const Unit& u, int wr, int wc, int fr, int fq) const {
        const int row0 = u.pm * BM + wr * 64 + fr, col0 = u.pn * BM + wc * 32 + 4 * fq;
        f32x4 bv[2][2];
#pragma unroll
        for (int bj = 0; bj < 2; ++bj)
#pragma unroll
            for (int n = 0; n < 2; ++n) bv[bj][n] = bias ? *(const f32x4*)(bias + col0 + bj * HALF + n * 16) : (f32x4){0.f, 0.f, 0.f, 0.f};
#pragma unroll
        for (int ai = 0; ai < 2; ++ai)
#pragma unroll
            for (int m = 0; m < 4; ++m) { const size_t off = (size_t)(row0 + ai * HALF + m * 16) * ldc + col0;
#pragma unroll
                for (int bj = 0; bj < 2; ++bj)
#pragma unroll
                    for (int n = 0; n < 2; ++n) { const f32x4 bs = *(const f32x4*)(base + off + bj * HALF + n * 16);
                        *(f32x4*)(out + off + bj * HALF + n * 16) = bs * alpha + acc[ai][bj][m][n] + bv[bj][n]; }
                if (m & 1) asm volatile("" ::: "memory"); }
    }
};
struct PanelStats {
    unsigned* xbuf;
    unsigned* cnt;
    unsigned* tmo;
    int ntn; float eps;
    unsigned code;
    __device__ __forceinline__ bool run(const f32x4 (&v)[2][2][4][2], const Unit& u, int wr, int wc, int fr, int fq, PG8_LAS unsigned char* lds, int wid, int lane) const {
        typedef float f32x2v __attribute__((ext_vector_type(2)));
        PG8_LAS f32x2v* P = (PG8_LAS f32x2v*)lds;
        PG8_LAS f32x2v* S = (PG8_LAS f32x2v*)(lds + 8192);
        PG8_LAS unsigned* flag = (PG8_LAS unsigned*)(lds + 8192 + 2048);
        const unsigned tag = code & 3u;
        if (wid == 0 && lane == 0) flag[0] = 0u;
#pragma unroll
        for (int ai = 0; ai < 2; ++ai)
#pragma unroll
            for (int m = 0; m < 4; ++m) {
                float s = 0.f;
#pragma unroll
                for (int bj = 0; bj < 2; ++bj)
#pragma unroll
                    for (int n = 0; n < 2; ++n) { const f32x4 x = v[ai][bj][m][n]; s += (x[0] + x[1]) + (x[2] + x[3]); }
                s += __shfl_xor(s, 16); s += __shfl_xor(s, 32);
                const float mw = s * (1.0f / 64.0f); float q = 0.f;
#pragma unroll
                for (int bj = 0; bj < 2; ++bj)
#pragma unroll
                    for (int n = 0; n < 2; ++n) { const f32x4 d = v[ai][bj][m][n] - mw; q += (d[0] * d[0] + d[1] * d[1]) + (d[2] * d[2] + d[3] * d[3]); }
                q += __shfl_xor(q, 16); q += __shfl_xor(q, 32);
                if (fq == 0) P[(ai * HALF + wr * 64 + m * 16 + fr) * 4 + wc] = (f32x2v){mw, q};
            }
        asm volatile("s_waitcnt lgkmcnt(0)" ::: "memory"); __builtin_amdgcn_s_barrier(); asm volatile("" ::: "memory");
        const int row = wid * 32 + (lane & 31);
        if (lane < 32) {
            const f32x2v a = P[row * 4 + 0], b = P[row * 4 + 1], c = P[row * 4 + 2], d = P[row * 4 + 3];
            const float mt0 = (a.x + b.x + c.x + d.x) * 0.25f;
            const float da = a.x - mt0, db = b.x - mt0, dc = c.x - mt0, dd = d.x - mt0;
            const float m20 = (a.y + b.y) + (c.y + d.y) + 64.0f * ((da * da + db * db) + (dc * dc + dd * dd));
            const unsigned m2bits = (__float_as_uint(m20) & ~3u) | tag;
            unsigned long long* slot = (unsigned long long*)xbuf + (size_t)(u.pm * BM + row) * 4;
            __hip_atomic_store(slot + u.pn, ((unsigned long long)m2bits << 32) | __float_as_uint(mt0), __ATOMIC_RELAXED, __HIP_MEMORY_SCOPE_AGENT);
            float mt[4], m2[4]; unsigned sp = 0u;
            for (;;) {
                bool ok = true;
#pragma unroll
                for (int t = 0; t < 4; ++t) {
                    if (t < ntn && t != u.pn) { const unsigned long long w = __hip_atomic_load(slot + t, __ATOMIC_RELAXED, __HIP_MEMORY_SCOPE_AGENT); const unsigned hb = (unsigned)(w >> 32);
                        ok = ok && ((hb & 3u) == tag); mt[t] = __uint_as_float((unsigned)w); m2[t] = __uint_as_float(hb & ~3u); }
                    else { mt[t] = 0.f; m2[t] = 0.f; }
                }
                if (ok) break;
                __builtin_amdgcn_s_sleep(1);
                if (++sp > (1u << 20)) { flag[0] = 1u; unsigned expect = 0u; __hip_atomic_compare_exchange_strong(tmo + 1, &expect, code | (unsigned)(u.pm & 0xff), __ATOMIC_RELAXED, __ATOMIC_RELAXED, __HIP_MEMORY_SCOPE_AGENT);
                    __hip_atomic_store(tmo, 1u, __ATOMIC_RELAXED, __HIP_MEMORY_SCOPE_AGENT); break; }
            }
            float ms = 0.f;
#pragma unroll
            for (int t = 0; t < 4; ++t) { if (t == u.pn) { mt[t] = mt0; m2[t] = __uint_as_float(m2bits & ~3u); } ms += mt[t]; }
            const float mean = ms / (float)ntn; float q = 0.f;
#pragma unroll
            for (int t = 0; t < 4; ++t) if (t < ntn) { const float dm = mt[t] - mean; q += m2[t] + 256.0f * dm * dm; }
            S[row] = (f32x2v){mean, 1.0f / sqrtf(q / (256.0f * (float)ntn) + eps)};
        }
        asm volatile("s_waitcnt lgkmcnt(0)" ::: "memory"); __builtin_amdgcn_s_barrier(); asm volatile("" ::: "memory");
        return flag[0] != 0u;
    }
};
template <bool FINAL> struct EpiPostLn {
    static constexpr bool PERM = true, AFTER_DRAIN = true;
    float* out; bf16_t* xn; int ldc; const float* bias; const float* gamma; const float* beta; PanelStats st; static constexpr float alpha = 1.4142135623730951f;
    __device__ __forceinline__ void fused(f32x4 (&acc)[2][2][4][2], const Unit& u, int wr, int wc, int fr, int fq, PG8_LAS unsigned char* lds, int wid, int lane) const {
        typedef float f32x2v __attribute__((ext_vector_type(2)));
        const PG8_LAS f32x2v* S = (const PG8_LAS f32x2v*)(lds + 8192);
        const int col0 = u.pn * BM + wc * 32 + 8 * fq;
        if (bias) {
#pragma unroll
            for (int bj = 0; bj < 2; ++bj)
#pragma unroll
                for (int n = 0; n < 2; ++n) { const f32x4 bv = *(const f32x4*)(bias + col0 + bj * HALF + n * 4);
#pragma unroll
                    for (int ai = 0; ai < 2; ++ai)
#pragma unroll
                        for (int m = 0; m < 4; ++m) acc[ai][bj][m][n] += bv; }
        }
        f32x4 gv[2][2], bv[2][2];
#pragma unroll
        for (int bj = 0; bj < 2; ++bj)
#pragma unroll
            for (int n = 0; n < 2; ++n) { gv[bj][n] = *(const f32x4*)(gamma + col0 + bj * HALF + n * 4); bv[bj][n] = *(const f32x4*)(beta + col0 + bj * HALF + n * 4); }
#pragma unroll
        for (int ai = 0; ai < 2; ++ai) {
            u32x4 t[4][2];
#pragma unroll
            for (int mm = 0; mm < 4; ++mm) { const size_t off = (size_t)(u.pm * BM + ai * HALF + wr * 64 + mm * 16 + fr) * ldc + col0;
#pragma unroll
                for (int bj = 0; bj < 2; ++bj) t[mm][bj] = *(const u32x4*)(xn + off + bj * HALF); }
            asm volatile("" : "+v"(t[0][0]), "+v"(t[0][1]), "+v"(t[1][0]), "+v"(t[1][1]), "+v"(t[2][0]), "+v"(t[2][1]), "+v"(t[3][0]), "+v"(t[3][1]));
            if (ai == 0) asm volatile("" : "+v"(gv[0][0]), "+v"(gv[0][1]), "+v"(gv[1][0]), "+v"(gv[1][1]), "+v"(bv[0][0]), "+v"(bv[0][1]), "+v"(bv[1][0]), "+v"(bv[1][1]));
#pragma unroll
            for (int mm = 0; mm < 4; ++mm)
#pragma unroll
                for (int bj = 0; bj < 2; ++bj) { const u32x4 w = t[mm][bj];
                    acc[ai][bj][mm][0] += (f32x4){__uint_as_float(w.x << 16), __uint_as_float(w.x & 0xffff0000u), __uint_as_float(w.y << 16), __uint_as_float(w.y & 0xffff0000u)} * alpha;
                    acc[ai][bj][mm][1] += (f32x4){__uint_as_float(w.z << 16), __uint_as_float(w.z & 0xffff0000u), __uint_as_float(w.w << 16), __uint_as_float(w.w & 0xffff0000u)} * alpha; }
            asm volatile("" ::: "memory");
        }
        const bool bad = st.run(acc, u, wr, wc, fr, fq, lds, wid, lane);
        const float qnan = __builtin_nanf("");
#pragma unroll
        for (int ai = 0; ai < 2; ++ai)
#pragma unroll
            for (int m = 0; m < 4; ++m) { const int r = ai * HALF + wr * 64 + m * 16 + fr; const f32x2v sr = S[r]; const size_t off = (size_t)(u.pm * BM + r) * ldc + col0;
#pragma unroll
                for (int bj = 0; bj < 2; ++bj) {
                    f32x4 o0 = (acc[ai][bj][m][0] - sr.x) * sr.y * gv[bj][0] + bv[bj][0], o1 = (acc[ai][bj][m][1] - sr.x) * sr.y * gv[bj][1] + bv[bj][1];
                    if (bad) { o0 = (f32x4){qnan, qnan, qnan, qnan}; o1 = o0; }
                    if (FINAL) { *(f32x4*)(out + off + bj * HALF) = o0; *(f32x4*)(out + off + bj * HALF + 4) = o1; }
                    else { u32x4 w; w.x = cvt_pk_bf16(o0[0], o0[1]); w.y = cvt_pk_bf16(o0[2], o0[3]); w.z = cvt_pk_bf16(o1[0], o1[1]); w.w = cvt_pk_bf16(o1[2], o1[3]); *(u32x4*)(xn + off + bj * HALF) = w; } }
                asm volatile("" ::: "memory"); }
    }
};
template <class Epi, class Sched, bool ALIGN_EPI = false, bool SP2 = false>
__device__ __forceinline__ void gemm_phase(PG8_LAS unsigned char* lds, const Gemm g, const Sched& S, const Epi& E, const int tid_in) {
    int tid_l = tid_in; asm volatile("" : "+v"(tid_l));
    const int tid = tid_l, wid = __builtin_amdgcn_readfirstlane(tid >> 6), lane = tid & 63, wr = wid >> 2, wc = wid & 3, fr = lane & 15, fq = lane >> 4;
    const int K = g.K, nt = K / BK;
    unsigned voffA[2], voffB[2];
#pragma unroll
    for (int i = 0; i < 2; ++i) { int R, C; stage_rc(tid * 16 + i * 8192, R, C); const int Rb = Epi::PERM ? ((R & ~31) + perm32(R & 31)) : R;
        voffA[i] = (unsigned)(R * g.lda + C) * 2u; voffB[i] = (unsigned)(Rb * K + C) * 2u; }
    const size_t kstep = (size_t)(BK * 2);
    const size_t hstepA = (size_t)HALF * g.lda * 2, hstepB = (size_t)HALF * K * 2;
    const size_t tstepA = 2 * hstepA, tstepB = 2 * hstepB;
    const unsigned ldsw = (unsigned)wid * 1024u;
    const int aoff = lds_byte(wr * 64 + fr, fq * 8), boff = lds_byte(wc * 32 + fr, fq * 8);
#define PG8_SA(b, h) (((b) * 2 + (h)) * HTB)
#define PG8_SB(b, h) ((4 + (b) * 2 + (h)) * HTB)
#define PG8_STAGE(bufoff, gbase, voff) do { _Pragma("unroll") for (int _i = 0; _i < 2; ++_i) \
        __builtin_amdgcn_global_load_lds((const unsigned*)((const char*)(gbase) + (voff)[_i]), (PG8_LAS unsigned*)(lds + (bufoff) + ldsw + _i * 8192), 16, 0, 0); } while (0)
#define PG8_LDA(dst, b, h) do { _Pragma("unroll") for (int m = 0; m < 4; ++m) _Pragma("unroll") for (int k = 0; k < 2; ++k) dst[m][k] = *(const PG8_LAS bf16x8*)(lds + PG8_SA(b, h) + aoff + m * 2048 + k * 1024); } while (0)
#define PG8_LDB(dst, b, h) do { _Pragma("unroll") for (int n = 0; n < 2; ++n) _Pragma("unroll") for (int k = 0; k < 2; ++k) dst[n][k] = *(const PG8_LAS bf16x8*)(lds + PG8_SB(b, h) + boff + n * 2048 + k * 1024); } while (0)
#define PG8_MMA(ai, bj, At, Bt) do { __builtin_amdgcn_s_setprio(1); _Pragma("unroll") for (int m = 0; m < 4; ++m) _Pragma("unroll") for (int n = 0; n < 2; ++n) _Pragma("unroll") for (int k = 0; k < 2; ++k) \
        acc[ai][bj][m][n] = __builtin_amdgcn_mfma_f32_16x16x32_bf16(Bt[n][k], At[m][k], acc[ai][bj][m][n], 0, 0, 0); __builtin_amdgcn_s_setprio(0); } while (0)
#define PG8_WAIT_V(n) asm volatile("s_waitcnt vmcnt(" #n ")" ::: "memory")
#define PG8_WAIT_L(n) asm volatile("s_waitcnt lgkmcnt(" #n ")" ::: "memory")
#define PG8_BAR __builtin_amdgcn_s_barrier()
#define PG8_SCHED __builtin_amdgcn_sched_barrier(0)
    Unit cur, nxt; int ui = 0;
    if (!S.next(0, cur)) return;
    f32x4 acc[2][2][4][2];
#pragma unroll
    for (int a = 0; a < 2; ++a)
#pragma unroll
        for (int b = 0; b < 2; ++b)
#pragma unroll
            for (int m = 0; m < 4; ++m)
#pragma unroll
                for (int n = 0; n < 2; ++n) acc[a][b][m][n] = (f32x4){0.f, 0.f, 0.f, 0.f};
    bf16x8 At[4][2], B0[2][2], B1[2][2];
    const char* cA = (const char*)g.A + (size_t)cur.pm * tstepA; const char* cB = (const char*)g.Bt + (size_t)cur.pn * tstepB;
    S.a_ready(cur);
    if constexpr (SP2) {
        PG8_STAGE(PG8_SB(0, 0), cB, voffB); PG8_STAGE(PG8_SB(0, 1), cB + hstepB, voffB); PG8_STAGE(PG8_SA(0, 0), cA, voffA); PG8_STAGE(PG8_SA(0, 1), cA + hstepA, voffA);
        if (wr == 1) PG8_BAR;
        PG8_WAIT_V(2); PG8_BAR;
        PG8_STAGE(PG8_SB(1, 0), cB + kstep, voffB); PG8_STAGE(PG8_SA(1, 0), cA + kstep, voffA); PG8_STAGE(PG8_SB(1, 1), cB + hstepB + kstep, voffB);
        PG8_WAIT_V(6); PG8_BAR;
    } else {
        PG8_STAGE(PG8_SB(0, 0), cB, voffB); PG8_STAGE(PG8_SA(0, 0), cA, voffA); PG8_STAGE(PG8_SB(0, 1), cB + hstepB, voffB); PG8_STAGE(PG8_SA(0, 1), cA + hstepA, voffA);
        if (wr == 1) PG8_BAR;
        PG8_WAIT_V(4); PG8_BAR;
        PG8_STAGE(PG8_SB(1, 0), cB + kstep, voffB); PG8_STAGE(PG8_SA(1, 0), cA + kstep, voffA); PG8_STAGE(PG8_SB(1, 1), cB + hstepB + kstep, voffB);
        PG8_WAIT_V(6); PG8_BAR;
    }
    for (;;) {
        const bool has_next = S.next(ui + 1, nxt);
        const char* nA = has_next ? (const char*)g.A + (size_t)nxt.pm * tstepA : cA; const char* nB = has_next ? (const char*)g.Bt + (size_t)nxt.pn * tstepB : cB;
        for (int t = 0; t < nt; t += 2) {
            const bool last = (t == nt - 2);
            const char* a1 = cA + (size_t)(t + 1) * kstep;
            const char* a2 = last ? nA : cA + (size_t)(t + 2) * kstep; const char* b2 = last ? nB : cB + (size_t)(t + 2) * kstep;
            const char* a3 = a2 + kstep; const char* b3 = b2 + kstep;
            if (last && has_next) S.a_ready(nxt);
            if constexpr (SP2) {
            PG8_LDB(B0, 0, 0); PG8_LDB(B1, 0, 1); PG8_SCHED; PG8_LDA(At, 0, 0); PG8_STAGE(PG8_SA(1, 1), a1 + hstepA, voffA);
            PG8_WAIT_V(8); PG8_WAIT_L(0); PG8_BAR; PG8_MMA(0, 0, At, B0); PG8_MMA(0, 1, At, B1); PG8_BAR; PG8_SCHED;
            PG8_LDA(At, 0, 1); PG8_STAGE(PG8_SB(0, 0), b2, voffB); PG8_STAGE(PG8_SB(0, 1), b2 + hstepB, voffB); PG8_STAGE(PG8_SA(0, 0), a2, voffA);
            PG8_WAIT_V(8); PG8_WAIT_L(0); PG8_BAR; PG8_MMA(1, 0, At, B0); PG8_MMA(1, 1, At, B1); PG8_BAR; PG8_SCHED;
            PG8_LDB(B0, 1, 0); PG8_LDB(B1, 1, 1); PG8_SCHED; PG8_LDA(At, 1, 0); PG8_STAGE(PG8_SA(0, 1), a2 + hstepA, voffA);
            PG8_WAIT_V(8); PG8_WAIT_L(0); PG8_BAR; PG8_MMA(0, 0, At, B0); PG8_MMA(0, 1, At, B1); PG8_BAR; PG8_SCHED;
            PG8_LDA(At, 1, 1); PG8_STAGE(PG8_SB(1, 0), b3, voffB); PG8_STAGE(PG8_SB(1, 1), b3 + hstepB, voffB); PG8_STAGE(PG8_SA(1, 0), a3, voffA);
            PG8_WAIT_V(8); PG8_WAIT_L(0); PG8_BAR; PG8_MMA(1, 0, At, B0); PG8_MMA(1, 1, At, B1); PG8_BAR; PG8_SCHED;
            } else {
            PG8_LDB(B0, 0, 0); PG8_SCHED; PG8_LDA(At, 0, 0); PG8_STAGE(PG8_SA(1, 1), a1 + hstepA, voffA);
            PG8_WAIT_L(8); PG8_BAR; PG8_WAIT_L(0); PG8_MMA(0, 0, At, B0); PG8_BAR; PG8_SCHED;
            PG8_LDB(B1, 0, 1); PG8_STAGE(PG8_SB(0, 0), b2, voffB);
            PG8_BAR; PG8_WAIT_L(0); PG8_MMA(0, 1, At, B1); PG8_BAR;
            PG8_LDA(At, 0, 1); PG8_STAGE(PG8_SA(0, 0), a2, voffA);
            PG8_BAR; PG8_WAIT_L(0); PG8_MMA(1, 0, At, B0); PG8_BAR; PG8_SCHED;
            PG8_STAGE(PG8_SB(0, 1), b2 + hstepB, voffB);
            PG8_WAIT_V(6); PG8_BAR; PG8_MMA(1, 1, At, B1); PG8_BAR;
            PG8_LDB(B0, 1, 0); PG8_SCHED; PG8_LDA(At, 1, 0); PG8_STAGE(PG8_SA(0, 1), a2 + hstepA, voffA);
            PG8_WAIT_L(8); PG8_BAR; PG8_WAIT_L(0); PG8_MMA(0, 0, At, B0); PG8_BAR; PG8_SCHED;
            PG8_LDB(B1, 1, 1); PG8_STAGE(PG8_SB(1, 0), b3, voffB);
            PG8_BAR; PG8_WAIT_L(0); PG8_MMA(0, 1, At, B1); PG8_BAR;
            PG8_LDA(At, 1, 1); PG8_STAGE(PG8_SA(1, 0), a3, voffA);
            PG8_BAR; PG8_WAIT_L(0); PG8_MMA(1, 0, At, B0); PG8_BAR; PG8_SCHED;
            PG8_STAGE(PG8_SB(1, 1), b3 + hstepB, voffB);
            PG8_WAIT_V(6); PG8_BAR; PG8_MMA(1, 1, At, B1); PG8_BAR;
            }
        }
        if constexpr (ALIGN_EPI) { if (wr == 0) PG8_BAR; }
        if constexpr (!Epi::AFTER_DRAIN) { E(acc, cur, wr, wc, fr, fq); S.done(cur); }
        if (!has_next) break;
#pragma unroll
        for (int a = 0; a < 2; ++a)
#pragma unroll
            for (int b = 0; b < 2; ++b)
#pragma unroll
                for (int m = 0; m < 4; ++m)
#pragma unroll
                    for (int n = 0; n < 2; ++n) acc[a][b][m][n] = (f32x4){0.f, 0.f, 0.f, 0.f};
        cur = nxt; cA = nA; cB = nB; ++ui;
        if constexpr (ALIGN_EPI) { if (wr == 1) PG8_BAR; }
    }
    PG8_WAIT_V(0);
    if constexpr (!ALIGN_EPI) { if (wr == 0) PG8_BAR; }
    PG8_BAR;
    if constexpr (Epi::AFTER_DRAIN) { E.fused(acc, cur, wr, wc, fr, fq, lds, wid, lane); S.done(cur); }
#undef PG8_SA
#undef PG8_SB
#undef PG8_STAGE
#undef PG8_LDA
#undef PG8_LDB
#undef PG8_MMA
#undef PG8_WAIT_V
#undef PG8_WAIT_L
#undef PG8_BAR
#undef PG8_SCHED
}
}

#ifndef PG8_SP2
#define PG8_SP2 true
#endif
#ifndef PG8_ALIGN
#define PG8_ALIGN true
#endif

constexpr int NWAVES = 8;
constexpr int D = 1024, BATCH = 8, SEQ = 2048, M = BATCH * SEQ, DG = 2048, NH = 2 * DG, NGRP = 8, GDIM = 256, GBLK = 128, FF = 4096;
constexpr float LN_EPS = 1e-5f, ALPHA = 1.4142135623730951f;
constexpr size_t MiB = 1u << 20;
constexpr size_t WS_CTL = 0, CTL_ZERO_BYTES = 1 * MiB;
constexpr size_t WS_WSM = 1 * MiB;
constexpr size_t WS_XBUF = 3 * MiB;
constexpr size_t WS_VPART = 4 * MiB;
constexpr size_t WS_WAIN = 8 * MiB, WS_WAOUT = 16 * MiB, WS_WBIN = 20 * MiB, WS_WBOUT = 26 * MiB, WS_W1 = 28 * MiB, WS_W2 = 44 * MiB;
constexpr size_t WS_XN = 64 * MiB;
constexpr size_t WS_H = 96 * MiB;
constexpr size_t WS_END = 224 * MiB;
constexpr int LDS_BYTES = 147456, MISC_OFF = 131072 + 1024;
constexpr int CW_BAR = 4096, CW_SEAM = 16384, SEAM_BANK = 64 * 64, CW_PSYNC = CW_SEAM + 4 * SEAM_BANK, CW_PMASK = CW_PSYNC + 10 * SEAM_BANK, CW_WCNT = CW_PMASK + SEAM_BANK, CTL_WORDS = CW_WCNT + 16 * 64;

#define GAS __attribute__((address_space(1)))
#define LAS __attribute__((address_space(3)))
typedef unsigned short bf16;
typedef unsigned v4u __attribute__((ext_vector_type(4)));
typedef unsigned v2u __attribute__((ext_vector_type(2)));
typedef float f32x4 __attribute__((ext_vector_type(4)));
typedef short bf16x8 __attribute__((ext_vector_type(8)));
#define LDS_WAIT() asm volatile("s_waitcnt lgkmcnt(0)" ::: "memory")
__device__ __forceinline__ unsigned pk2(float lo, float hi) { return pg8::cvt_pk_bf16(lo, hi); }
__device__ __forceinline__ float bflo(unsigned w) { return __uint_as_float(w << 16); }
__device__ __forceinline__ float bfhi(unsigned w) { return __uint_as_float(w & 0xffff0000u); }
__device__ __forceinline__ float wave_sum(float v) {
#pragma unroll
    for (int o = 1; o < 64; o <<= 1) v += __shfl_xor(v, o);
    return v;
}

__device__ __forceinline__ void p0_load_item(const float* W, int N, int item, int lane, f32x4 (&v)[8]) {
    const int nblk = N / 32, kb = item / nblk, nb = item % nblk; const float* src = W + (size_t)(64 * kb + 8 * (lane & 7)) * N + 32 * nb + 4 * (lane >> 3);
#pragma unroll
    for (int j = 0; j < 8; ++j) v[j] = *(const f32x4*)(src + (size_t)j * N);
}
__device__ __forceinline__ void p0_store_item(bf16* WT, int K, int N, int item, int lane, const f32x4 (&v)[8]) {
    const int nblk = N / 32, kb = item / nblk, nb = item % nblk; bf16* dst = WT + (size_t)(32 * nb + 4 * (lane >> 3)) * K + 64 * kb + 8 * (lane & 7);
#pragma unroll
    for (int i = 0; i < 4; ++i) { v4u o; o.x = pk2(v[0][i], v[1][i]); o.y = pk2(v[2][i], v[3][i]); o.z = pk2(v[4][i], v[5][i]); o.w = pk2(v[6][i], v[7][i]); *(v4u*)(dst + (size_t)i * K) = o; }
}
__device__ __forceinline__ void p0_store_item_wt(bf16* WT, int K, int N, int item, int lane, const f32x4 (&v)[8]) {
    const int nblk = N / 32, kb = item / nblk, nb = item % nblk; bf16* dst = WT + (size_t)(32 * nb + 4 * (lane >> 3)) * K + 64 * kb + 8 * (lane & 7);
#pragma unroll
    for (int i = 0; i < 4; ++i) { v4u o; o.x = pk2(v[0][i], v[1][i]); o.y = pk2(v[2][i], v[3][i]); o.z = pk2(v[4][i], v[5][i]); o.w = pk2(v[6][i], v[7][i]); bf16* q = dst + (size_t)i * K;
        asm volatile("global_store_dwordx4 %0, %1, off sc1\n\ts_nop 1" :: "v"(q), "v"(o) : "memory"); }
}
struct P0Mat { const float* W; bf16* WT; int K, N, item; };
#define XB_TMO      128
#define XB_XCNT(j)  (256  + 64 * (j))
#define XB_XSUB(j)  (1280 + 64 * (j))
#define XB_XGEN(j)  (2304 + 64 * (j))
#define XB_TOP      3328
#define XB_TOPGEN   3392
#define XCD_BAR_WORDS 3456
#define XB_SPIN_CAP (1u << 18)

__device__ __forceinline__ unsigned xb_ld(unsigned* p)              { return __hip_atomic_load(p, __ATOMIC_RELAXED, __HIP_MEMORY_SCOPE_AGENT); }
__device__ __forceinline__ unsigned xb_add(unsigned* p, unsigned v) { return __hip_atomic_fetch_add(p, v, __ATOMIC_RELAXED, __HIP_MEMORY_SCOPE_AGENT); }
__device__ __forceinline__ unsigned xb_xcc_id() { return (unsigned)__builtin_amdgcn_s_getreg((3 << 11) | 20) & 0xFu; }
#define XB_SPIN(cond, bar) do { unsigned _sp = 0; while (cond) { __builtin_amdgcn_s_sleep(1); \
    if ((++_sp & 255u) == 0u) { if (xb_ld(&(bar)[XB_TMO])) break; if (_sp > XB_SPIN_CAP) { atomicAdd(&(bar)[XB_TMO], 1u); break; } } } } while (0)

struct XcdBarrier {
    unsigned* bar; unsigned x;
    volatile LAS unsigned* st;
};

__device__ __forceinline__ XcdBarrier xcd_barrier_post(unsigned* bar, volatile LAS unsigned* st) {
    XcdBarrier b; b.bar = bar; b.x = xb_xcc_id(); b.st = st;
    if (threadIdx.x == 0) (void)xb_add(&bar[XB_XCNT(b.x)], 1u);
    return b;
}
__device__ __forceinline__ void xcd_barrier_complete(unsigned* bar, unsigned x, unsigned& nloc, unsigned& nx) {
    const unsigned G = gridDim.x * gridDim.y * gridDim.z;
    unsigned sum, cnt, mine, sp = 0u;
    for (;;) {
        sum = 0u; cnt = 0u; mine = 0u;
#pragma unroll
        for (unsigned j = 0; j < 16; ++j) { const unsigned c = xb_ld(&bar[XB_XCNT(j)]); sum += c; cnt += (c > 0u) ? 1u : 0u; mine = (j == x) ? c : mine; }
        if (sum == G) break;
        __builtin_amdgcn_s_sleep(1);
        if ((++sp & 255u) == 0u) { if (xb_ld(&bar[XB_TMO])) break; if (sp > XB_SPIN_CAP) { atomicAdd(&bar[XB_TMO], 1u); break; } }
    }
    nloc = mine > 0u ? mine : 1u; nx = cnt > 0u ? cnt : 1u;
}

__device__ __forceinline__ void xcd_barrier(const XcdBarrier& b) {
    asm volatile("s_waitcnt vmcnt(0)" ::: "memory");
    __syncthreads();
    if (threadIdx.x == 0) {
        unsigned* bar = b.bar;
        __builtin_amdgcn_s_waitcnt(0);
        unsigned nloc = b.st[0], nx = b.st[1];
        if (nloc == 0u) { xcd_barrier_complete(bar, b.x, nloc, nx); b.st[0] = nloc; b.st[1] = nx; }
        const unsigned old = xb_add(&bar[XB_XSUB(b.x)], 1u);
        const unsigned gen = old / nloc;
        if (old + 1u == (gen + 1u) * nloc) {
            __builtin_amdgcn_fence(__ATOMIC_RELEASE, "agent");
            asm volatile("s_waitcnt vmcnt(0)" ::: "memory");
            const unsigned og = xb_add(&bar[XB_TOP], 1u);
            const unsigned tg = og / nx;
            if (og + 1u == (tg + 1u) * nx) xb_add(&bar[XB_TOPGEN], 1u);
            else XB_SPIN(xb_ld(&bar[XB_TOPGEN]) == tg, bar);
            __builtin_amdgcn_fence(__ATOMIC_ACQUIRE, "agent");
            xb_add(&bar[XB_XGEN(b.x)], 1u);
            asm volatile("s_waitcnt vmcnt(0)" ::: "memory");
        } else {
            XB_SPIN(xb_ld(&bar[XB_XGEN(b.x)]) == gen, bar);
            __builtin_amdgcn_fence(__ATOMIC_ACQUIRE, "agent");
            asm volatile("s_waitcnt vmcnt(0)" ::: "memory");
        }
    }
    __syncthreads();
}
struct Args { const float* in[16]; float* out; unsigned char* ws; };

__device__ __forceinline__ int lane_id_now() { unsigned z = 0u; asm volatile("" : "+s"(z)); return (int)__builtin_amdgcn_mbcnt_hi(~0u, __builtin_amdgcn_mbcnt_lo(~0u, z)); }
__device__ __forceinline__ void* karg(int idx) {
    int off = idx * 8; asm volatile("" : "+s"(off));
    const char __attribute__((address_space(4)))* ka = (const char __attribute__((address_space(4)))*)__builtin_amdgcn_kernarg_segment_ptr();
    return *(void* const __attribute__((address_space(4)))*)(ka + off);
}
#define KIN(i) ((const float*)karg(i))
#define KOUT() ((float*)karg(16))
#define KWS() ((unsigned char*)karg(17))

template <class Filler> __device__ __forceinline__ void xcd_barrier_fill(const XcdBarrier& b, const Filler& filler, const int tid_in) {
    asm volatile("s_waitcnt vmcnt(0)" ::: "memory");
    __syncthreads();
    if (tid_in == 0) {
        unsigned* bar = b.bar;
        __builtin_amdgcn_s_waitcnt(0);
        unsigned nloc = b.st[0], nx = b.st[1];
        if (nloc == 0u) { xcd_barrier_complete(bar, b.x, nloc, nx); b.st[0] = nloc; b.st[1] = nx; }
        const unsigned old = xb_add(&bar[XB_XSUB(b.x)], 1u);
        const unsigned gen = old / nloc;
        if (old + 1u == (gen + 1u) * nloc) {
            __builtin_amdgcn_fence(__ATOMIC_RELEASE, "agent");
            asm volatile("s_waitcnt vmcnt(0)" ::: "memory");
            const unsigned og = xb_add(&bar[XB_TOP], 1u);
            const unsigned tg = og / nx;
            if (og + 1u == (tg + 1u) * nx) xb_add(&bar[XB_TOPGEN], 1u);
            else XB_SPIN(xb_ld(&bar[XB_TOPGEN]) == tg, bar);
            __builtin_amdgcn_fence(__ATOMIC_ACQUIRE, "agent");
            xb_add(&bar[XB_XGEN(b.x)], 1u);
            asm volatile("s_waitcnt vmcnt(0)" ::: "memory");
        } else {
            XB_SPIN(xb_ld(&bar[XB_XGEN(b.x)]) == gen, bar);
            __builtin_amdgcn_fence(__ATOMIC_ACQUIRE, "agent");
            asm volatile("s_waitcnt vmcnt(0)" ::: "memory");
        }
    }
    if (tid_in >= 64) filler();
    __syncthreads();
}
constexpr int I_AIN = (D / 64) * (NH / 32), I_AOUT = (DG / 64) * (D / 32), I_BIN = (D / 64) * (3 * D / 32), I_BOUT = (D / 64) * (D / 32), I_W1 = (D / 64) * (FF / 32), I_W2 = (FF / 64) * (D / 32);
constexpr int N_DEFER = I_AOUT + 2 * I_W1 + 2 * I_W2 + I_BIN + I_BOUT, N_FILL_WAVES = 256 * 7;
__host__ __device__ __forceinline__ constexpr int win_start(int w) { return w <= 0 ? 0 : w == 1 ? 1536 : w == 2 ? 3072 : w == 3 ? 5120 : w == 4 ? 6656 : (6656 + 1152 * (w - 4) < N_DEFER ? 6656 + 1152 * (w - 4) : N_DEFER); }
static_assert(win_start(1) >= I_AOUT && win_start(2) >= I_AOUT + I_W1 && win_start(3) >= I_AOUT + I_W1 + I_W2 && win_start(4) >= I_AOUT + I_W1 + I_W2 + I_BIN && win_start(6) >= I_AOUT + I_W1 + I_W2 + I_BIN + I_BOUT && win_start(7) >= N_DEFER - I_W2 && win_start(8) >= N_DEFER, "deferred conversion schedule: an item first used after sync d sits in a window <= d - 2");
__device__ __forceinline__ unsigned wg_items_in_window(int w, int bid_) {
    const int lo = win_start(w) + bid_ * 7, hi = win_start(w + 1); int n = 0;
    for (int r = 0; r < 2; ++r) { int k = hi - (lo + N_FILL_WAVES * r); k = k < 0 ? 0 : (k > 7 ? 7 : k); n += k; }
    return (unsigned)n;
}
template <class Filler> __device__ __forceinline__ void panel_sync(unsigned* cnt, const unsigned* pmask, const Filler& filler, const int tid_in, const unsigned* cnt_prev = nullptr, const unsigned* pmask_next = nullptr, const unsigned* wcnt = nullptr, int w_lo = 0, int w_hi = 0, unsigned* wpub = nullptr, int wprev = -1) {
    asm volatile("s_waitcnt vmcnt(0)" ::: "memory");
    __syncthreads();
    if (tid_in == 0) {
        const unsigned mk = __hip_atomic_load(pmask, __ATOMIC_RELAXED, __HIP_MEMORY_SCOPE_AGENT);
        bool same = __builtin_popcount(mk) == 1;
        if (pmask_next) same = same && (__hip_atomic_load(pmask_next, __ATOMIC_RELAXED, __HIP_MEMORY_SCOPE_AGENT) == mk);
        if (!same) { __builtin_amdgcn_fence(__ATOMIC_RELEASE, "agent"); }
        asm volatile("s_waitcnt vmcnt(0)" ::: "memory");
        if (wpub) { int b_ = blockIdx.x; asm volatile("" : "+s"(b_)); const unsigned npub = wg_items_in_window(wprev, b_); if (npub) (void)__hip_atomic_fetch_add(wpub, npub, __ATOMIC_RELAXED, __HIP_MEMORY_SCOPE_AGENT); }
        (void)__hip_atomic_fetch_add(cnt, 1u, __ATOMIC_RELAXED, __HIP_MEMORY_SCOPE_AGENT);
        unsigned sp = 0u;
        while (__hip_atomic_load(cnt, __ATOMIC_RELAXED, __HIP_MEMORY_SCOPE_AGENT) < 4u) { __builtin_amdgcn_s_sleep(1); if (++sp > (1u << 22)) break; }
        if (cnt_prev) { sp = 0u; while (__hip_atomic_load(cnt_prev, __ATOMIC_RELAXED, __HIP_MEMORY_SCOPE_AGENT) < 4u) { __builtin_amdgcn_s_sleep(1); if (++sp > (1u << 22)) break; } }
        if (wcnt) for (int w = w_lo; w < w_hi; ++w) { const unsigned need = (unsigned)(win_start(w + 1) - win_start(w)); sp = 0u; while (__hip_atomic_load(wcnt + 64 * w, __ATOMIC_RELAXED, __HIP_MEMORY_SCOPE_AGENT) < need) { __builtin_amdgcn_s_sleep(1); if (++sp > (1u << 22)) break; } }
        __builtin_amdgcn_fence(__ATOMIC_ACQUIRE, "agent");
        asm volatile("s_waitcnt vmcnt(0)" ::: "memory");
    }
    if (tid_in >= 64) filler();
    __syncthreads();
}
struct PanelOrder {
    int pm, q, upw, il;
    __device__ __forceinline__ void init(int G_, int c_, int upw_) { asm volatile("" : "+s"(c_));     pg8::StaticOrder S; S.init(M, D, G_, c_); pg8::Unit u; S.next(0, u); pm = u.pm; q = u.pn; upw = upw_; il = 0; }
    __device__ __forceinline__ bool next(int i, pg8::Unit& u) const { if (i >= upw) return false; u.pm = pm; u.pn = il ? q + 4 * i : q * upw + i; return true; }
    __device__ __forceinline__ void a_ready(const pg8::Unit&) const {}
    __device__ __forceinline__ void done(const pg8::Unit&) const {}
};
__device__ __forceinline__ void deferred_item(int it, int lane) {
    unsigned char* const ws = KWS(); int r = it; P0Mat m;
    if (r < I_AOUT) m = P0Mat{KIN(9), (bf16*)(ws + WS_WAOUT), DG, D, r};
    else if ((r -= I_AOUT) < I_W1) m = P0Mat{KIN(14), (bf16*)(ws + WS_W1), D, FF, r};
    else if ((r -= I_W1) < I_W2) m = P0Mat{KIN(15), (bf16*)(ws + WS_W2), FF, D, r};
    else if ((r -= I_W2) < I_BIN) m = P0Mat{KIN(11), (bf16*)(ws + WS_WBIN), D, 3 * D, r};
    else if ((r -= I_BIN) < I_BOUT) m = P0Mat{KIN(13), (bf16*)(ws + WS_WBOUT), D, D, r};
    else if ((r -= I_BOUT) < I_W1) m = P0Mat{KIN(14) + (size_t)D * FF, (bf16*)(ws + WS_W1) + (size_t)D * FF, D, FF, r};
    else { r -= I_W1; m = P0Mat{KIN(15) + (size_t)D * FF, (bf16*)(ws + WS_W2) + (size_t)D * FF, FF, D, r}; }
    f32x4 v[8]; p0_load_item(m.W, m.N, m.item, lane, v); p0_store_item_wt(m.WT, m.K, m.N, m.item, lane, v);
}
__global__ void __launch_bounds__(NWAVES * 64, 2) fwd_kernel(Args args) {
    extern __shared__ __attribute__((aligned(16))) unsigned char lds_raw[];
    cg::grid_group grid = cg::this_grid();
    LAS unsigned char* lds = (LAS unsigned char*)lds_raw;
    const int wave_s = __builtin_amdgcn_readfirstlane((int)(threadIdx.x >> 6));
#define TID_NOW() (wave_s * 64 + lane_id_now())
#define PHASE_IDS() int tid_l = TID_NOW(); asm volatile("" : "+v"(tid_l)); const int tid = tid_l, lane = tid & 63, wave = __builtin_amdgcn_readfirstlane(tid >> 6), gw = bid * NWAVES + wave; (void)lane; (void)gw
    const int G = gridDim.x, bid = blockIdx.x, NGW = G * NWAVES;

    if (threadIdx.x < 64) ((LAS unsigned*)(lds + MISC_OFF))[threadIdx.x] = 0u;
    __syncthreads();
    if (karg(17) == nullptr) grid.sync();
    (void)xcd_barrier_post((unsigned*)(KWS() + WS_CTL) + CW_BAR, (volatile LAS unsigned*)(lds + MISC_OFF + 32));
    if (threadIdx.x == 0) { PanelOrder po; po.init((int)gridDim.x, (int)blockIdx.x, 1); (void)__hip_atomic_fetch_or((unsigned*)(KWS() + WS_CTL) + CW_PMASK + 64 * po.pm, 1u << xb_xcc_id(), __ATOMIC_RELAXED, __HIP_MEMORY_SCOPE_AGENT); }
#define FILLER_BODY(sn_) [&]() { int tf_ = TID_NOW(), bf_ = blockIdx.x; asm volatile("" : "+v"(tf_), "+s"(bf_)); const int lo_ = win_start(sn_), hi_ = win_start((sn_) + 1); for (int it_ = lo_ + bf_ * 7 + (tf_ >> 6) - 1; it_ < hi_; it_ += N_FILL_WAVES) deferred_item(it_, tf_ & 63); }
#define GSYNC(w_) do { XcdBarrier xb_; xb_.bar = (unsigned*)(KWS() + WS_CTL) + CW_BAR; xb_.x = xb_xcc_id(); xb_.st = (volatile LAS unsigned*)(lds + MISC_OFF + 32); const int sn_ = __builtin_amdgcn_readfirstlane(w_); \
        xcd_barrier_fill(xb_, FILLER_BODY(sn_), TID_NOW()); } while (0)
#define PSYNC(slot, pm_, w_) do { const int sn_ = __builtin_amdgcn_readfirstlane(w_); panel_sync((unsigned*)(KWS() + WS_CTL) + CW_PSYNC + (slot) * SEAM_BANK + 64 * (pm_), (const unsigned*)(KWS() + WS_CTL) + CW_PMASK + 64 * (pm_), FILLER_BODY(sn_), TID_NOW(), nullptr, nullptr, (const unsigned*)(KWS() + WS_CTL) + CW_WCNT, sn_ >= 2 ? sn_ - 2 : 0, sn_ >= 2 ? sn_ - 1 : 0, (unsigned*)(KWS() + WS_CTL) + CW_WCNT + 64 * (sn_ - 1), sn_ - 1); } while (0)
#ifndef PROBE_P0
#define PROBE_P0 1
#endif
#ifndef PROBE_SGU
#define PROBE_SGU 1
#endif
#ifndef PROBE_CONV
#define PROBE_CONV 1
#endif
#ifndef PROBE_B1
#define PROBE_B1 1
#endif

    {
        PHASE_IDS();
        unsigned char* const ws = KWS();
#pragma unroll 1
        for (int rep = 0; rep < PROBE_P0; ++rep) {
        { const float* const p_ain = KIN(3);
          for (int it = gw; it < I_AIN; it += NGW) { f32x4 v0[8]; p0_load_item(p_ain, NH, it, lane, v0); p0_store_item((bf16*)(ws + WS_WAIN), D, NH, it, lane, v0); } }
        const float* const xp = KIN(0); bf16* const XNp = (bf16*)(ws + WS_XN);
        for (int m = gw; m < M; m += 4 * NGW) {
            f32x4 va[4][4];
#pragma unroll
            for (int r = 0; r < 4; ++r) { const f32x4* xr = (const f32x4*)(xp + (size_t)(m + r * NGW) * D) + lane;
#pragma unroll
                for (int j = 0; j < 4; ++j) va[r][j] = xr[64 * j]; }
#pragma unroll
            for (int r = 0; r < 4; ++r) { v2u* o8 = (v2u*)(XNp + (size_t)(m + r * NGW) * D) + lane;
#pragma unroll
                for (int j = 0; j < 4; ++j) { v2u w; w.x = pk2(va[r][j].x, va[r][j].y); w.y = pk2(va[r][j].z, va[r][j].w); o8[64 * j] = w; } }
        }
        const float* const wsp = KIN(7); bf16* const WSMp = (bf16*)(ws + WS_WSM);
        for (int i = (bid * 512 + tid) * 4; i < NGRP * GBLK * GBLK; i += G * 512 * 4) {
            const int t = (i >> 7) & 127, s = i & 127; f32x4 v = *(const f32x4*)(wsp + i);
            if (t < 64 && s >= 64) v = (f32x4){0.f, 0.f, 0.f, 0.f};
            v2u w; w.x = pk2(v.x, v.y); w.y = pk2(v.z, v.w); *(v2u*)(WSMp + i) = w;
        }
        }
    }
    GSYNC(0);

#pragma unroll 1
    for (int layer = 0; layer < 2; ++layer) {
        if (layer == 0) {
            { unsigned char* const ws = KWS();
              pg8::Gemm g{(bf16*)(ws + WS_XN), (bf16*)(ws + WS_WAIN), M, NH, D, D}; PanelOrder S; S.init(G, bid, 4); S.il = 1;     pg8::EpiBf16<1, true> E{(bf16*)(ws + WS_H), NH, KIN(4), (float*)(ws + WS_VPART), DG / 256};
              pg8::gemm_phase<pg8::EpiBf16<1, true>, PanelOrder, PG8_ALIGN, PG8_SP2>(lds, g, S, E, TID_NOW()); }
            { PanelOrder po; po.init(G, bid, 4); PSYNC(4, po.pm, 1); }
            {
                PHASE_IDS();
                unsigned char* const ws = KWS();
                bf16* const Hl = (bf16*)(ws + WS_H); const float* const VPl = (const float*)(ws + WS_VPART); const bf16* const WSMl = (const bf16*)(ws + WS_WSM);
                const float* const avg_l = KIN(5); const float* const avb_l = KIN(6); const float* const abs_l = KIN(8); float* const outl = KOUT(); (void)outl;
                LAS bf16* WA = (LAS bf16*)lds;
                LAS bf16* VT = (LAS bf16*)(lds + 34816);
                LAS float* ST = (LAS float*)(lds + 104448);
                const int wr = wave >> 2, wc = wave & 3, fr = lane & 15, fq = lane >> 4;
                PanelOrder po; po.init(G, bid, 4);
#pragma unroll 1
                for (int pass = 0; pass < PROBE_SGU; ++pass)
#pragma unroll 1
                for (int jj = 0; jj < 4; ++jj) {
                    const int idx = 4 * po.q + jj, nb = 2 * po.pm + (idx >> 3), g = idx & 7, row0 = nb * GBLK;
                    __syncthreads();
#pragma unroll
                    for (int i = 0; i < 4; ++i) { const int ch = tid + i * 512, t = ch >> 4, sc = ch & 15;
                        const v4u w = *(const v4u*)(WSMl + (size_t)(g * GBLK + t) * GBLK + sc * 8); *(LAS v4u*)(WA + t * 136 + sc * 8) = w; }
                    { const int r = tid >> 2, q4 = tid & 3; const f32x4* pp = (const f32x4*)(VPl + (size_t)(row0 + r) * 64 + q4 * 16); float ssum = 0.f, qsum = 0.f;
#pragma unroll
                      for (int i = 0; i < 4; ++i) { const f32x4 v = pp[i]; ssum += v.x + v.z; qsum += v.y + v.w; }
                      ssum += __shfl_xor(ssum, 1); ssum += __shfl_xor(ssum, 2); qsum += __shfl_xor(qsum, 1); qsum += __shfl_xor(qsum, 2);
                      const float mean = ssum * (1.f / DG), var = qsum * (1.f / DG) - mean * mean;
                      if (q4 == 0) { ST[2 * r] = mean; ST[2 * r + 1] = 1.f / sqrtf(var + LN_EPS); } }
                    const int sh = wave >> 2, cq = wave & 3, cl = lane & 7, rl = lane >> 3;
                    v4u raw[8];
#pragma unroll
                    for (int j = 0; j < 8; ++j) raw[j] = *(const v4u*)(Hl + (size_t)(row0 + 64 * sh + 8 * rl + j) * NH + DG + g * GDIM + 64 * cq + 8 * cl);
                    const f32x4 g0 = *(const f32x4*)(avg_l + g * GDIM + 64 * cq + 8 * cl), g1 = *(const f32x4*)(avg_l + g * GDIM + 64 * cq + 8 * cl + 4);
                    const f32x4 b0 = *(const f32x4*)(avb_l + g * GDIM + 64 * cq + 8 * cl), b1 = *(const f32x4*)(avb_l + g * GDIM + 64 * cq + 8 * cl + 4);
                    __syncthreads();
                    float mu[8], rs[8];
#pragma unroll
                    for (int j2 = 0; j2 < 4; ++j2) { const f32x4 t4 = *(const LAS f32x4*)(ST + 2 * (64 * sh + 8 * rl + 2 * j2)); mu[2 * j2] = t4.x; rs[2 * j2] = t4.y; mu[2 * j2 + 1] = t4.z; rs[2 * j2 + 1] = t4.w; }
                    asm volatile("" : "+v"(raw[0]), "+v"(raw[1]), "+v"(raw[2]), "+v"(raw[3]), "+v"(raw[4]), "+v"(raw[5]), "+v"(raw[6]), "+v"(raw[7]));
#pragma unroll
                    for (int e = 0; e < 8; ++e) { const float ge = e < 4 ? g0[e & 3] : g1[e & 3], be = e < 4 ? b0[e & 3] : b1[e & 3]; float y[8];
#pragma unroll
                        for (int j = 0; j < 8; ++j) { const unsigned wd = raw[j][e >> 1]; const float xv = (e & 1) ? bfhi(wd) : bflo(wd); y[j] = (xv - mu[j]) * rs[j] * ge + be; }
                        v4u o; o.x = pk2(y[0], y[1]); o.y = pk2(y[2], y[3]); o.z = pk2(y[4], y[5]); o.w = pk2(y[6], y[7]);
                        *(LAS v4u*)(VT + (64 * cq + 8 * cl + e) * 136 + 64 * sh + 8 * rl) = o; }
                    v4u uu[4][2];
#pragma unroll
                    for (int m = 0; m < 4; ++m)
#pragma unroll
                        for (int p = 0; p < 2; ++p) uu[m][p] = *(const v4u*)(Hl + (size_t)(row0 + wr * 64 + m * 16 + fr) * NH + g * GDIM + wc * 64 + p * 32 + 8 * fq);
                    float bsv[4];
#pragma unroll
                    for (int m = 0; m < 4; ++m) bsv[m] = abs_l[g * GBLK + wr * 64 + m * 16 + fr];
                    __syncthreads();
                    f32x4 acc[4][4];
#pragma unroll
                    for (int m = 0; m < 4; ++m)
#pragma unroll
                        for (int n = 0; n < 4; ++n) acc[m][n] = (f32x4){0.f, 0.f, 0.f, 0.f};
#pragma unroll
                    for (int kk = 0; kk < 4; ++kk) {
                        bf16x8 af[4], bfr[4];
#pragma unroll
                        for (int m = 0; m < 4; ++m) af[m] = *(const LAS bf16x8*)(WA + (wr * 64 + m * 16 + fr) * 136 + kk * 32 + fq * 8);
#pragma unroll
                        for (int n = 0; n < 4; ++n) bfr[n] = *(const LAS bf16x8*)(VT + (wc * 64 + (n >> 1) * 32 + 8 * (fr >> 2) + 4 * (n & 1) + (fr & 3)) * 136 + kk * 32 + fq * 8);
#pragma unroll
                        for (int m = 0; m < 4; ++m)
#pragma unroll
                            for (int n = 0; n < 4; ++n) acc[m][n] = __builtin_amdgcn_mfma_f32_16x16x32_bf16(bfr[n], af[m], acc[m][n], 0, 0, 0);
                    }
                    asm volatile("" : "+v"(uu[0][0]), "+v"(uu[0][1]), "+v"(uu[1][0]), "+v"(uu[1][1]), "+v"(uu[2][0]), "+v"(uu[2][1]), "+v"(uu[3][0]), "+v"(uu[3][1]));
#pragma unroll
                    for (int m = 0; m < 4; ++m) { const int t = wr * 64 + m * 16 + fr; const float bs = bsv[m];
#pragma unroll
                        for (int p = 0; p < 2; ++p) { bf16* up = Hl + (size_t)(row0 + t) * NH + g * GDIM + wc * 64 + p * 32 + 8 * fq;
                            const v4u u4 = uu[m][p]; const f32x4 a0 = acc[m][2 * p] + bs, a1 = acc[m][2 * p + 1] + bs; v4u o;
                            o.x = pk2(bflo(u4.x) * a0.x, bfhi(u4.x) * a0.y); o.y = pk2(bflo(u4.y) * a0.z, bfhi(u4.y) * a0.w);
                            o.z = pk2(bflo(u4.z) * a1.x, bfhi(u4.z) * a1.y); o.w = pk2(bflo(u4.w) * a1.z, bfhi(u4.w) * a1.w);
                            if (pass == PROBE_SGU - 1) *(v4u*)up = o; else *(v4u*)((bf16*)outl + (size_t)(row0 + t) * DG + g * GDIM + wc * 64 + p * 32 + 8 * fq) = o; } }
                }
                __syncthreads();
            }
        } else {
#pragma unroll 1
            for (int rep = 0; rep < PROBE_B1; ++rep)
            { unsigned char* const ws = KWS();
              pg8::Gemm g{(bf16*)(ws + WS_XN), (bf16*)(ws + WS_WBIN), M, 3 * D, D, D}; PanelOrder S; S.init(G, bid, 3); pg8::EpiBf16<0> E{(bf16*)(ws + WS_H), NH, nullptr, nullptr, 0};
              pg8::gemm_phase<pg8::EpiBf16<0>, PanelOrder, PG8_ALIGN, PG8_SP2>(lds, g, S, E, TID_NOW()); }
            { PanelOrder po; po.init(G, bid, 4); unsigned* const ctl = (unsigned*)(KWS() + WS_CTL); const int sn_ = 6;
              panel_sync(ctl + CW_PSYNC + 6 * SEAM_BANK + 64 * po.pm, ctl + CW_PMASK + 64 * po.pm, FILLER_BODY(sn_), TID_NOW(),
                         (po.pm % 8) != 0 ? ctl + CW_PSYNC + 6 * SEAM_BANK + 64 * (po.pm - 1) : nullptr, ((po.pm + 1) % 8) != 0 ? ctl + CW_PMASK + 64 * (po.pm + 1) : nullptr, ctl + CW_WCNT, sn_ - 2, sn_ - 1, ctl + CW_WCNT + 64 * (sn_ - 1), sn_ - 1); }
            {
                PHASE_IDS();
                unsigned char* const ws = KWS();
                bf16* const Hl = (bf16*)(ws + WS_H); const float* const bcv_l = KIN(12); bf16* const XNl = (bf16*)(ws + WS_XN); (void)XNl;
                const int cgp = tid & 127, rsub = tid >> 7, ch = cgp * 8;
                float w0[8], w1[8], w2[8];
#pragma unroll
                for (int e = 0; e < 8; ++e) { w0[e] = bcv_l[ch + e]; w1[e] = bcv_l[D + ch + e]; w2[e] = bcv_l[2 * D + ch + e]; }
                PanelOrder po; po.init(G, bid, 4);
#pragma unroll 1
                for (int pass = 0; pass < PROBE_CONV; ++pass)
                { const int it = 4 * po.pm + po.q;
                    const int t0 = it * 64 + rsub * 16; float p1[8], p2[8];
                    if ((t0 % SEQ) == 0) {
#pragma unroll
                        for (int e = 0; e < 8; ++e) { p1[e] = 0.f; p2[e] = 0.f; }
                    } else {
                        const v4u c2 = *(const v4u*)(Hl + (size_t)(t0 - 2) * NH + D + ch), h2 = *(const v4u*)(Hl + (size_t)(t0 - 2) * NH + 2 * D + ch);
                        const v4u c1 = *(const v4u*)(Hl + (size_t)(t0 - 1) * NH + D + ch), h1 = *(const v4u*)(Hl + (size_t)(t0 - 1) * NH + 2 * D + ch);
#pragma unroll
                        for (int e = 0; e < 4; ++e) { p2[2 * e] = bflo(c2[e]) * bflo(h2[e]); p2[2 * e + 1] = bfhi(c2[e]) * bfhi(h2[e]); p1[2 * e] = bflo(c1[e]) * bflo(h1[e]); p1[2 * e + 1] = bfhi(c1[e]) * bfhi(h1[e]); }
                    }
#pragma unroll 1
                    for (int r4 = 0; r4 < 16; r4 += 8) {
                        v4u bb[8], cc[8], hh[8];
#pragma unroll
                        for (int r = 0; r < 8; ++r) { const bf16* bp = Hl + (size_t)(t0 + r4 + r) * NH + ch; bb[r] = *(const v4u*)bp; cc[r] = *(const v4u*)(bp + D); hh[r] = *(const v4u*)(bp + 2 * D); }
                        asm volatile("" : "+v"(bb[0]), "+v"(bb[1]), "+v"(bb[2]), "+v"(bb[3]), "+v"(cc[0]), "+v"(cc[1]), "+v"(cc[2]), "+v"(cc[3]), "+v"(hh[0]), "+v"(hh[1]), "+v"(hh[2]), "+v"(hh[3]));
                        asm volatile("" : "+v"(bb[4]), "+v"(bb[5]), "+v"(bb[6]), "+v"(bb[7]), "+v"(cc[4]), "+v"(cc[5]), "+v"(cc[6]), "+v"(cc[7]), "+v"(hh[4]), "+v"(hh[5]), "+v"(hh[6]), "+v"(hh[7]));
#pragma unroll
                        for (int r = 0; r < 8; ++r) { v4u o;
#pragma unroll
                            for (int e = 0; e < 4; ++e) {
                                const float q0 = bflo(cc[r][e]) * bflo(hh[r][e]), q1 = bfhi(cc[r][e]) * bfhi(hh[r][e]);
                                const float o0 = bflo(bb[r][e]) * (w0[2 * e] * p2[2 * e] + w1[2 * e] * p1[2 * e] + w2[2 * e] * q0);
                                const float o1 = bfhi(bb[r][e]) * (w0[2 * e + 1] * p2[2 * e + 1] + w1[2 * e + 1] * p1[2 * e + 1] + w2[2 * e + 1] * q1);
                                o[e] = pk2(o0, o1); p2[2 * e] = p1[2 * e]; p2[2 * e + 1] = p1[2 * e + 1]; p1[2 * e] = q0; p1[2 * e + 1] = q1;
                            }
                            bf16* bp = Hl + (size_t)(t0 + r4 + r) * NH + ch;
                            if (pass == PROBE_CONV - 1) *(v4u*)bp = o; else *(v4u*)(XNl + (size_t)(t0 + r4 + r) * D + ch) = o; }
                    }
                }
            }
        }
        { PanelOrder po; po.init(G, bid, 4); unsigned* const ctl = (unsigned*)(KWS() + WS_CTL); const int sn_ = __builtin_amdgcn_readfirstlane(layer == 0 ? 2 : 7);
          panel_sync(ctl + CW_PSYNC + (layer == 0 ? 7 : 8) * SEAM_BANK + 64 * po.pm, ctl + CW_PMASK + 64 * po.pm, FILLER_BODY(sn_), TID_NOW(), nullptr, nullptr, ctl + CW_WCNT, sn_ - 2, sn_ - 1, ctl + CW_WCNT + 64 * (sn_ - 1), sn_ - 1); }
        { unsigned char* const ws = KWS();
          const pg8::Gemm gmix = layer == 0 ? pg8::Gemm{(bf16*)(ws + WS_H), (bf16*)(ws + WS_WAOUT), M, D, DG, NH} : pg8::Gemm{(bf16*)(ws + WS_H), (bf16*)(ws + WS_WBOUT), M, D, D, NH};
          pg8::StaticOrder S; S.init(M, D, G, bid);
          pg8::PanelStats st{(unsigned*)(ws + WS_XBUF), (unsigned*)(ws + WS_CTL) + CW_SEAM + (layer * 2 + 0) * SEAM_BANK, (unsigned*)(ws + WS_CTL), D / 256, LN_EPS, 0x700u + (unsigned)(layer * 2 + 0)};
          pg8::EpiPostLn<false> E{nullptr, (bf16*)(ws + WS_XN), D, layer == 0 ? KIN(10) : nullptr, KIN(1) + (size_t)(layer * 2 + 0) * D, KIN(2) + (size_t)(layer * 2 + 0) * D, st};
          pg8::gemm_phase<pg8::EpiPostLn<false>, pg8::StaticOrder, false, PG8_SP2>(lds, gmix, S, E, TID_NOW()); }
        { PanelOrder po; po.init(G, bid, 4); PSYNC(layer * 2 + 0, po.pm, layer == 0 ? 3 : 8); }
        { unsigned char* const ws = KWS();
          pg8::Gemm g{(bf16*)(ws + WS_XN), (bf16*)(ws + WS_W1) + (size_t)layer * D * FF, M, FF, D, D}; PanelOrder S; S.init(G, bid, 4); pg8::EpiBf16<2> E{(bf16*)(ws + WS_H), FF, nullptr, nullptr, 0};
          pg8::gemm_phase<pg8::EpiBf16<2>, PanelOrder, PG8_ALIGN, PG8_SP2>(lds, g, S, E, TID_NOW()); }
        { PanelOrder po; po.init(G, bid, 4); PSYNC(layer * 2 + 1, po.pm, layer == 0 ? 4 : 9); }
        { unsigned char* const ws = KWS();
          pg8::Gemm g{(bf16*)(ws + WS_H), (bf16*)(ws + WS_W2) + (size_t)layer * D * FF, M, D, FF, FF}; pg8::StaticOrder S; S.init(M, D, G, bid);
          pg8::PanelStats st{(unsigned*)(ws + WS_XBUF), (unsigned*)(ws + WS_CTL) + CW_SEAM + (layer * 2 + 1) * SEAM_BANK, (unsigned*)(ws + WS_CTL), D / 256, LN_EPS, 0x780u + (unsigned)(layer * 2 + 1)};
          if (layer == 0) { pg8::EpiPostLn<false> E{nullptr, (bf16*)(ws + WS_XN), D, nullptr, KIN(1) + (size_t)(layer * 2 + 1) * D, KIN(2) + (size_t)(layer * 2 + 1) * D, st};
            pg8::gemm_phase<pg8::EpiPostLn<false>, pg8::StaticOrder, false, PG8_SP2>(lds, g, S, E, TID_NOW()); }
          else { pg8::EpiPostLn<true> E{KOUT(), (bf16*)(ws + WS_XN), D, nullptr, KIN(1) + (size_t)(layer * 2 + 1) * D, KIN(2) + (size_t)(layer * 2 + 1) * D, st};
            pg8::gemm_phase<pg8::EpiPostLn<true>, pg8::StaticOrder, false, PG8_SP2>(lds, g, S, E, TID_NOW()); } }
        if (layer == 0) { PanelOrder po; po.init(G, bid, 4); PSYNC(5, po.pm, 5); }
    }
}

extern "C" void kernel_launch(void* const* d_in, const int* in_sizes, int n_in, void* d_out, int out_size, void* d_ws, size_t ws_size, hipStream_t stream) {
    static int grid = 0;
    if (grid == 0) {
        if (n_in != 16 || in_sizes[0] != M * D || out_size != M * D || ws_size < WS_END) { fprintf(stderr, "kernel_launch: unexpected shapes (n_in %d, in0 %d, out %d, ws %zu)\n", n_in, n_in > 0 ? in_sizes[0] : -1, out_size, ws_size); grid = -1; return; }
        int dev = 0, cus = 0, per_cu = 0;
        if (hipGetDevice(&dev) != hipSuccess || hipDeviceGetAttribute(&cus, hipDeviceAttributeMultiprocessorCount, dev) != hipSuccess) { grid = -1; return; }
        if (hipFuncSetAttribute((const void*)fwd_kernel, hipFuncAttributeMaxDynamicSharedMemorySize, LDS_BYTES) != hipSuccess) { fprintf(stderr, "kernel_launch: hipFuncSetAttribute failed\n"); grid = -1; return; }
        if (hipOccupancyMaxActiveBlocksPerMultiprocessor(&per_cu, (const void*)fwd_kernel, NWAVES * 64, LDS_BYTES) != hipSuccess || per_cu < 1) { fprintf(stderr, "kernel_launch: occupancy query reports %d\n", per_cu); (void)hipGetLastError(); grid = -1; return; }
        if (cus != 256) { fprintf(stderr, "kernel_launch: built for 256 CUs, found %d\n", cus); grid = -1; return; }
        grid = cus;
        fprintf(stderr, "kernel_launch: cus %d per_cu %d grid %d\n", cus, per_cu, grid);
    }
    if (grid < 0) return;
    if (hipMemsetAsync((char*)d_ws + WS_CTL, 0, (size_t)CTL_WORDS * 4, stream) != hipSuccess) { fprintf(stderr, "kernel_launch: hipMemsetAsync failed\n"); return; }
    Args a{};
    for (int i = 0; i < 16; ++i) a.in[i] = (const float*)d_in[i];
    a.out = (float*)d_out; a.ws = (unsigned char*)d_ws;
    void* kargs[] = {&a};
    const hipError_t e = hipLaunchCooperativeKernel((const void*)fwd_kernel, dim3(grid), dim3(NWAVES * 64), kargs, LDS_BYTES, stream);
    if (e != hipSuccess) fprintf(stderr, "kernel_launch: cooperative launch failed: %s (grid %d)\n", hipGetErrorString(e), grid);
}
```
